# Optimizing an MI355X kernel written in HIP

```python
import jax
import jax.numpy as jnp
from jax import lax
import numpy as np

D_MODEL = 1024
BATCH = 2
SEQ = 16384
DEPTH = 2

GRID_W = 64
CTX_LEN = 256
EPS = 1e-6

MLA_HEADS = D_MODEL // 128
MLA_NOPE = 64
MLA_ROPE = 32
MLA_V = 64
MLA_Q_RANK = D_MODEL // 4
MLA_KV_RANK = D_MODEL // 8
MLA_COLS = MLA_Q_RANK + MLA_KV_RANK + MLA_ROPE
MLA_SCALE = (MLA_NOPE + MLA_ROPE) ** -0.5
ROPE_FREQS = MLA_ROPE // 4
ROPE_BASE = 10000.0
Q_BLOCK = 128

RWKV_HEAD = 64
RWKV_DIM = D_MODEL // 2
RWKV_HEADS = RWKV_DIM // RWKV_HEAD
DECAY_LORA = 32
AAA_LORA = 32
GATE_LORA = 96
RWKV_COLS = 3 * RWKV_DIM + 2 * DECAY_LORA + 2 * AAA_LORA + GATE_LORA
RWKV_LN_EPS = 64e-5

IN_COLS = MLA_COLS + RWKV_COLS
MIX_WIDTH = MLA_HEADS * MLA_V + RWKV_DIM

CHUNK = 128
GM_WIDTH = D_MODEL
GM_GROUPS = 8
GM_GROUP_DIM = GM_WIDTH // GM_GROUPS
LN_EPS = 1e-5

N_EXPERTS = 32
TOP_K = 4
EXPERT_FF = D_MODEL
SWIGLU_LIMIT = 7.0
SWIGLU_ALPHA = 1.702
MOE_BLOCK = 128

N_EVEN = (DEPTH + 1) // 2
N_ODD = DEPTH // 2

kernel_name = 'hybrid_mla_rwkv7_gmlp_moe_diffusion_trunk'


def rms_norm(x, g):
    x32 = x.astype(jnp.float32)
    y = x32 * lax.rsqrt(jnp.mean(x32 * x32, axis=-1, keepdims=True) + EPS)
    return y.astype(x.dtype) * g


def layer_norm(x, g, b, eps):
    x32 = x.astype(jnp.float32)
    mu = jnp.mean(x32, axis=-1, keepdims=True)
    var = jnp.mean(jnp.square(x32 - mu), axis=-1, keepdims=True)
    return ((x32 - mu) * lax.rsqrt(var + eps)).astype(x.dtype) * g + b


def modulate(h, shift, scale):
    return h * (1 + scale) + shift


def axial_rope_tables(n_tokens):
    rows = n_tokens // GRID_W
    row = jnp.repeat(jnp.arange(rows), GRID_W)
    col = jnp.arange(rows * GRID_W) % GRID_W
    inv = ROPE_BASE ** (-jnp.arange(ROPE_FREQS, dtype=jnp.float32) / ROPE_FREQS)
    ang = jnp.stack([row[:, None] * inv, col[:, None] * inv], axis=1)
    return jnp.cos(ang), jnp.sin(ang)


def apply_axial_rope(x, cos, sin):
    xr = x.reshape(x.shape[:-1] + (2, 2, ROPE_FREQS))
    x1, x2 = xr[..., 0, :], xr[..., 1, :]
    cos = cos.astype(x.dtype)
    sin = sin.astype(x.dtype)
    out = jnp.stack([x1 * cos - x2 * sin, x2 * cos + x1 * sin], axis=-2)
    return out.reshape(x.shape)


def mla_q(p, q_norm, w_uq):
    q = rms_norm(p[..., :MLA_Q_RANK], q_norm) @ w_uq
    q = q.reshape(q.shape[:-1] + (MLA_HEADS, MLA_NOPE + MLA_ROPE))
    return q[..., :MLA_NOPE], q[..., MLA_NOPE:]


def mla_kv(p, kv_norm, w_ukv):
    c_kv = rms_norm(p[..., MLA_Q_RANK:MLA_Q_RANK + MLA_KV_RANK], kv_norm)
    kv = c_kv @ w_ukv
    kv = kv.reshape(kv.shape[:-1] + (MLA_HEADS, MLA_NOPE + MLA_V))
    k_rope = p[..., MLA_Q_RANK + MLA_KV_RANK:MLA_COLS]
    return kv[..., :MLA_NOPE], k_rope, kv[..., MLA_NOPE:]


def mla_attend(q_nope, q_rope, k_nope, k_rope, v):
    s = (jnp.einsum('bqhd,bkhd->bhqk', q_nope, k_nope, preferred_element_type=jnp.float32)
         + jnp.einsum('bqhd,bkd->bhqk', q_rope, k_rope, preferred_element_type=jnp.float32))
    p = jax.nn.softmax(s * MLA_SCALE, axis=-1).astype(v.dtype)
    return jnp.einsum('bhqk,bkhd->bqhd', p, v)


def mla_attend_blocked(q_nope, q_rope, k_nope, k_rope, v):
    b, s = q_nope.shape[:2]
    nb = s // Q_BLOCK
    def blocks(t):
        return t.reshape((b, nb, Q_BLOCK) + t.shape[2:]).swapaxes(0, 1)
    o = lax.map(lambda qs: mla_attend(qs[0], qs[1], k_nope, k_rope, v), (blocks(q_nope), blocks(q_rope)))
    return o.swapaxes(0, 1).reshape(b, s, MLA_HEADS * MLA_V)


def token_shift(p, mu_prev, mu_next):
    zero = jnp.zeros_like(p[:, :1])
    prev = jnp.concatenate([zero, p[:, :-1]], axis=1)
    nxt = jnp.concatenate([p[:, 1:], zero], axis=1)
    return p + mu_prev * (prev - p) + mu_next * (nxt - p)


def rwkv_prepare(p, mu_prev, mu_next, w0, w2, a0, a2, k_k, k_a):
    p = token_shift(p, mu_prev, mu_next)
    b, t, _ = p.shape
    o1, o2, o3 = RWKV_DIM, 2 * RWKV_DIM, 3 * RWKV_DIM
    o4 = o3 + 2 * DECAY_LORA
    o5 = o4 + 2 * AAA_LORA
    r, k, v = p[..., :o1], p[..., o1:o2], p[..., o2:o3]
    wd = jnp.tanh(p[..., o3:o4].reshape(b, t, 2, DECAY_LORA))
    ad = p[..., o4:o5].reshape(b, t, 2, AAA_LORA)
    gd = p[..., o5:]
    w = (w0 + jnp.einsum('btdl,dlc->btdc', wd, w2)).astype(jnp.float32)
    decay = jnp.exp(-jnp.exp(-jax.nn.softplus(-w) - 0.5)).astype(p.dtype)
    a = jax.nn.sigmoid(a0 + jnp.einsum('btdl,dlc->btdc', ad, a2))
    kk32 = (k * k_k).reshape(b, t, RWKV_HEADS, RWKV_HEAD).astype(jnp.float32)
    kk = kk32 * lax.rsqrt(jnp.maximum(jnp.sum(kk32 * kk32, axis=-1, keepdims=True), 1e-24))
    kk = kk.astype(p.dtype).reshape(b, t, RWKV_DIM)
    k_dir = k[:, :, None] * (1 + (a - 1) * k_a)
    b_dir = kk[:, :, None] * a
    return r, k, v, gd, decay, k_dir, -kk, b_dir


def wkv_scan(s0, decay, k, v, a_vec, b_vec, r, reverse):
    b, t, _ = k.shape
    def tm(z):
        return z.reshape(b, t, RWKV_HEADS, RWKV_HEAD).swapaxes(0, 1)
    xs = (tm(decay), tm(k), tm(v), tm(a_vec), tm(b_vec)) + (() if r is None else (tm(r),))
    def step(s, inp):
        w_t, k_t, v_t, a_t, b_t = inp[:5]
        sa = jnp.einsum('bhij,bhj->bhi', s, a_t)
        s = s * w_t[:, :, None, :] + sa[..., None] * b_t[:, :, None, :] + v_t[..., None] * k_t[:, :, None, :]
        y = None if r is None else jnp.einsum('bhij,bhj->bhi', s, inp[5])
        return s, y
    s, ys = lax.scan(step, s0, xs, reverse=reverse)
    y = None if r is None else ys.swapaxes(0, 1).reshape(b, t, RWKV_DIM)
    return s, y


def rwkv_readout(y, r, k, v, gd, g2, ln_w, ln_b, r_k):
    b, t, _ = y.shape
    yh = y.reshape(b, t, RWKV_HEADS, RWKV_HEAD).astype(jnp.float32)
    mu = jnp.mean(yh, axis=-1, keepdims=True)
    var = jnp.mean(jnp.square(yh - mu), axis=-1, keepdims=True)
    yn = ((yh - mu) * lax.rsqrt(var + RWKV_LN_EPS)).astype(y.dtype).reshape(b, t, RWKV_DIM) * ln_w + ln_b
    rkh = (r * k).reshape(b, t, RWKV_HEADS, RWKV_HEAD)
    bonus = jnp.sum(rkh * r_k, axis=-1, keepdims=True) * v.reshape(b, t, RWKV_HEADS, RWKV_HEAD)
    g = jax.nn.sigmoid(gd) @ g2
    return (yn + bonus.reshape(b, t, RWKV_DIM)) * g


def hybrid_mixer(h_lat, h_ctx, rope_cos, rope_sin, w_in, q_norm, w_uq, kv_norm, w_ukv,
                 mu_prev, mu_next, w0, w2, a0, a2, g2, k_k, k_a, r_k, ln_w, ln_b, w_out, ctx_out):
    b, s, _ = h_lat.shape
    p_lat = h_lat @ w_in
    p_ctx = h_ctx @ w_in
    qn_l, qr_l = mla_q(p_lat[..., :MLA_COLS], q_norm, w_uq)
    kn_l, kr_l, v_l = mla_kv(p_lat[..., :MLA_COLS], kv_norm, w_ukv)
    kn_c, kr_c, v_c = mla_kv(p_ctx[..., :MLA_COLS], kv_norm, w_ukv)
    qr_l = apply_axial_rope(qr_l, rope_cos[:, None], rope_sin[:, None])
    kr_l = apply_axial_rope(kr_l, rope_cos, rope_sin)
    kn_all = jnp.concatenate([kn_c, kn_l], axis=1)
    kr_all = jnp.concatenate([kr_c, kr_l], axis=1)
    v_all = jnp.concatenate([v_c, v_l], axis=1)
    o_lat = mla_attend_blocked(qn_l, qr_l, kn_all, kr_all, v_all)
    r_l, k_l, vv_l, gd_l, dec_l, kd_l, av_l, bd_l = rwkv_prepare(
        p_lat[..., MLA_COLS:], mu_prev, mu_next, w0, w2, a0, a2, k_k, k_a)
    r_c, k_c, vv_c, gd_c, dec_c, kd_c, av_c, bd_c = rwkv_prepare(
        p_ctx[..., MLA_COLS:], mu_prev, mu_next, w0, w2, a0, a2, k_k, k_a)
    s0 = jnp.zeros((b, RWKV_HEADS, RWKV_HEAD, RWKV_HEAD), h_lat.dtype)
    r_c_out = r_c if ctx_out else None
    s_cf, y_cf = wkv_scan(s0, dec_c[:, :, 0], kd_c[:, :, 0], vv_c, av_c, bd_c[:, :, 0], r_c_out, False)
    s_cb, y_cb = wkv_scan(s0, dec_c[:, :, 1], kd_c[:, :, 1], vv_c, av_c, bd_c[:, :, 1], r_c_out, True)
    _, y_lf = wkv_scan(s_cf, dec_l[:, :, 0], kd_l[:, :, 0], vv_l, av_l, bd_l[:, :, 0], r_l, False)
    _, y_lb = wkv_scan(s_cb, dec_l[:, :, 1], kd_l[:, :, 1], vv_l, av_l, bd_l[:, :, 1], r_l, True)
    rw_lat = rwkv_readout(y_lf + y_lb, r_l, k_l, vv_l, gd_l, g2, ln_w, ln_b, r_k)
    y_lat = jnp.concatenate([o_lat, rw_lat], axis=-1) @ w_out
    y_ctx = None
    if ctx_out:
        qn_c, qr_c = mla_q(p_ctx[..., :MLA_COLS], q_norm, w_uq)
        o_ctx = mla_attend(qn_c, qr_c, kn_c, kr_c, v_c).reshape(b, h_ctx.shape[1], MLA_HEADS * MLA_V)
        rw_ctx = rwkv_readout(y_cf + y_cb, r_c, k_c, vv_c, gd_c, g2, ln_w, ln_b, r_k)
        y_ctx = jnp.concatenate([o_ctx, rw_ctx], axis=-1) @ w_out
    return y_lat, y_ctx


def chunk_gmlp(h, w_in, vn_w, vn_b, w_s, b_s, w_out):
    b, t, _ = h.shape
    z = jax.nn.gelu(h @ w_in, approximate=False)
    u, v = z[..., :GM_WIDTH], z[..., GM_WIDTH:]
    v = layer_norm(v, vn_w, vn_b, LN_EPS).reshape(b, t // CHUNK, CHUNK, GM_GROUPS, GM_GROUP_DIM)
    s = jnp.einsum('gij,bnjgc->bnigc', w_s, v) + b_s.T[:, :, None]
    return (u * s.reshape(b, t, GM_WIDTH)) @ w_out


def moe_ffn(h, router_w, router_b, w_gu, b_gu, w_down, b_down):
    n_tok, d = h.shape
    logits = jnp.matmul(h, router_w, preferred_element_type=jnp.float32) + router_b.astype(jnp.float32)
    top_val, top_idx = lax.top_k(logits, TOP_K)
    gates = jax.nn.softmax(top_val, axis=-1).astype(h.dtype)
    n_assign = n_tok * TOP_K
    e_flat = top_idx.reshape(-1)
    order = jnp.argsort(e_flat)
    e_sorted = e_flat[order]
    tok_sorted = (order // TOP_K).astype(jnp.int32)
    gate_sorted = gates.reshape(-1)[order]
    counts = jnp.zeros((N_EXPERTS,), jnp.int32).at[e_flat].add(1)
    padded = (counts + MOE_BLOCK - 1) // MOE_BLOCK * MOE_BLOCK
    start = jnp.cumsum(counts) - counts
    pend = jnp.cumsum(padded)
    pstart = pend - padded
    dest = pstart[e_sorted] + jnp.arange(n_assign, dtype=jnp.int32) - start[e_sorted]
    n_rows = -(-n_assign // MOE_BLOCK) * MOE_BLOCK + N_EXPERTS * MOE_BLOCK
    n_blocks = n_rows // MOE_BLOCK
    row_tok = jnp.full((n_rows,), n_tok, jnp.int32).at[dest].set(tok_sorted)
    row_gate = jnp.zeros((n_rows,), h.dtype).at[dest].set(gate_sorted)
    blk_start = jnp.arange(n_blocks, dtype=jnp.int32) * MOE_BLOCK
    blk_expert = jnp.minimum(jnp.searchsorted(pend, blk_start, side='right'), N_EXPERTS - 1)
    h_ext = jnp.concatenate([h, jnp.zeros((1, d), h.dtype)], axis=0)
    def expert_block(args):
        tok, e = args
        gu = h_ext[tok] @ w_gu[e] + b_gu[e]
        x_glu = jnp.minimum(gu[:, :EXPERT_FF], SWIGLU_LIMIT)
        x_lin = jnp.clip(gu[:, EXPERT_FF:], -SWIGLU_LIMIT, SWIGLU_LIMIT)
        act = x_glu * jax.nn.sigmoid(SWIGLU_ALPHA * x_glu) * (x_lin + 1)
        return act @ w_down[e] + b_down[e]
    y = lax.map(expert_block, (row_tok.reshape(n_blocks, MOE_BLOCK), blk_expert))
    y = y.reshape(n_rows, d) * row_gate[:, None]
    return jnp.zeros((n_tok + 1, d), h.dtype).at[row_tok].add(y)[:n_tok]


def setup_inputs(seed: int = 0) -> dict:
    key = jax.random.key(seed)
    ks = iter(jax.random.split(key, 48))
    def nrm(shape, scale):
        return jax.random.normal(next(ks), shape, jnp.float32) * scale
    def gain(shape):
        return 1.0 + nrm(shape, 0.02)
    def unif(shape, lo, hi):
        return jax.random.uniform(next(ks), shape, jnp.float32, lo, hi)
    d = D_MODEL
    return {
        'x': nrm((BATCH, SEQ, d), 1.0),
        'c': nrm((BATCH, d), 1.0),
        'ctx': nrm((BATCH, CTX_LEN, d), 1.0),
        'c_ctx': nrm((d,), 1.0),
        'ada_w': nrm((DEPTH, d, 6 * d), 0.5 * d ** -0.5),
        'ada_b': nrm((DEPTH, 6 * d), 0.02),
        'norm_mix_pre': gain((DEPTH, d)),
        'norm_mix_post': gain((DEPTH, d)),
        'norm_ffn_pre': gain((DEPTH, d)),
        'norm_ffn_post': gain((DEPTH, d)),
        'router_w': nrm((DEPTH, d, N_EXPERTS), d ** -0.5),
        'router_b': nrm((DEPTH, N_EXPERTS), 0.01),
        'moe_w_gu': nrm((DEPTH, N_EXPERTS, d, 2 * EXPERT_FF), d ** -0.5),
        'moe_b_gu': nrm((DEPTH, N_EXPERTS, 2 * EXPERT_FF), 0.02),
        'moe_w_down': nrm((DEPTH, N_EXPERTS, EXPERT_FF, d), EXPERT_FF ** -0.5),
        'moe_b_down': nrm((DEPTH, N_EXPERTS, d), 0.02),
        'hy_w_in': nrm((N_EVEN, d, IN_COLS), d ** -0.5),
        'mla_q_norm': gain((N_EVEN, MLA_Q_RANK)),
        'mla_w_uq': nrm((N_EVEN, MLA_Q_RANK, MLA_HEADS * (MLA_NOPE + MLA_ROPE)), MLA_Q_RANK ** -0.5),
        'mla_kv_norm': gain((N_EVEN, MLA_KV_RANK)),
        'mla_w_ukv': nrm((N_EVEN, MLA_KV_RANK, MLA_HEADS * (MLA_NOPE + MLA_V)), MLA_KV_RANK ** -0.5),
        'rwkv_mu_prev': unif((N_EVEN, RWKV_COLS), 0.1, 0.45),
        'rwkv_mu_next': unif((N_EVEN, RWKV_COLS), 0.1, 0.45),
        'rwkv_w0': unif((N_EVEN, 2, RWKV_DIM), -6.0, 0.0),
        'rwkv_w2': nrm((N_EVEN, 2, DECAY_LORA, RWKV_DIM), 0.1),
        'rwkv_a0': nrm((N_EVEN, 2, RWKV_DIM), 0.5),
        'rwkv_a2': nrm((N_EVEN, 2, AAA_LORA, RWKV_DIM), 0.1),
        'rwkv_g2': nrm((N_EVEN, GATE_LORA, RWKV_DIM), GATE_LORA ** -0.5),
        'rwkv_k_k': 0.85 + nrm((N_EVEN, RWKV_DIM), 0.05),
        'rwkv_k_a': gain((N_EVEN, RWKV_DIM)),
        'rwkv_r_k': nrm((N_EVEN, RWKV_HEADS, RWKV_HEAD), 0.1),
        'rwkv_ln_w': gain((N_EVEN, RWKV_DIM)),
        'rwkv_ln_b': nrm((N_EVEN, RWKV_DIM), 0.02),
        'hy_w_out': nrm((N_EVEN, MIX_WIDTH, d), MIX_WIDTH ** -0.5),
        'gm_w_in': nrm((N_ODD, d, 2 * GM_WIDTH), d ** -0.5),
        'gm_v_norm_w': gain((N_ODD, GM_WIDTH)),
        'gm_v_norm_b': nrm((N_ODD, GM_WIDTH), 0.02),
        'gm_w_s': nrm((N_ODD, GM_GROUPS, CHUNK, CHUNK), CHUNK ** -0.5),
        'gm_b_s': nrm((N_ODD, GM_GROUPS, CHUNK), 0.02),
        'gm_w_out': nrm((N_ODD, GM_WIDTH, d), GM_WIDTH ** -0.5),
    }


def reference(x, c, ctx, c_ctx, ada_w, ada_b, norm_mix_pre, norm_mix_post, norm_ffn_pre, norm_ffn_post,
              router_w, router_b, moe_w_gu, moe_b_gu, moe_w_down, moe_b_down,
              hy_w_in, mla_q_norm, mla_w_uq, mla_kv_norm, mla_w_ukv,
              rwkv_mu_prev, rwkv_mu_next, rwkv_w0, rwkv_w2, rwkv_a0, rwkv_a2, rwkv_g2,
              rwkv_k_k, rwkv_k_a, rwkv_r_k, rwkv_ln_w, rwkv_ln_b, hy_w_out,
              gm_w_in, gm_v_norm_w, gm_v_norm_b, gm_w_s, gm_b_s, gm_w_out):
    b, s, d = x.shape
    rope_cos, rope_sin = axial_rope_tables(s)
    silu_c = jax.nn.silu(c)
    silu_cc = jax.nn.silu(c_ctx)
    for l in range(DEPTH):
        ctx_out = any(j % 2 == 0 for j in range(l + 1, DEPTH))
        need_ctx = (l % 2 == 0) or ctx_out
        mod = (silu_c @ ada_w[l] + ada_b[l])[:, None, :]
        sh1, sc1, g1, sh2, sc2, g2 = jnp.split(mod, 6, axis=-1)
        h = modulate(rms_norm(x, norm_mix_pre[l]), sh1, sc1)
        if need_ctx:
            modc = silu_cc @ ada_w[l] + ada_b[l]
            sh1c, sc1c, g1c, sh2c, sc2c, g2c = jnp.split(modc, 6, axis=-1)
            hc = modulate(rms_norm(ctx, norm_mix_pre[l]), sh1c, sc1c)
        if l % 2 == 0:
            e = l // 2
            y, yc = hybrid_mixer(h, hc, rope_cos, rope_sin, hy_w_in[e], mla_q_norm[e], mla_w_uq[e],
                                 mla_kv_norm[e], mla_w_ukv[e], rwkv_mu_prev[e], rwkv_mu_next[e],
                                 rwkv_w0[e], rwkv_w2[e], rwkv_a0[e], rwkv_a2[e], rwkv_g2[e],
                                 rwkv_k_k[e], rwkv_k_a[e], rwkv_r_k[e], rwkv_ln_w[e], rwkv_ln_b[e],
                                 hy_w_out[e], ctx_out)
        else:
            o = l // 2
            y = chunk_gmlp(h, gm_w_in[o], gm_v_norm_w[o], gm_v_norm_b[o], gm_w_s[o], gm_b_s[o], gm_w_out[o])
            yc = None
            if ctx_out:
                yc = chunk_gmlp(hc, gm_w_in[o], gm_v_norm_w[o], gm_v_norm_b[o], gm_w_s[o], gm_b_s[o], gm_w_out[o])
        x = x + g1 * rms_norm(y, norm_mix_post[l])
        hf = modulate(rms_norm(x, norm_ffn_pre[l]), sh2, sc2).reshape(b * s, d)
        f = moe_ffn(hf, router_w[l], router_b[l], moe_w_gu[l], moe_b_gu[l], moe_w_down[l], moe_b_down[l])
        x = x + g2 * rms_norm(f.reshape(b, s, d), norm_ffn_post[l])
        if ctx_out:
            ctx = ctx + g1c * rms_norm(yc, norm_mix_post[l])
            lc = ctx.shape[1]
            hfc = modulate(rms_norm(ctx, norm_ffn_pre[l]), sh2c, sc2c).reshape(b * lc, d)
            fc = moe_ffn(hfc, router_w[l], router_b[l], moe_w_gu[l], moe_b_gu[l], moe_w_down[l], moe_b_down[l])
            ctx = ctx + g2c * rms_norm(fc.reshape(b, lc, d), norm_ffn_post[l])
    return x
```

```cpp
#include <hip/hip_runtime.h>
#include <cstdio>
#include <cstdint>

typedef unsigned short bf16_t;
typedef short bf16x8 __attribute__((ext_vector_type(8)));
typedef short s16x4 __attribute__((ext_vector_type(4)));
typedef float f32x2 __attribute__((ext_vector_type(2)));
typedef float f32x4 __attribute__((ext_vector_type(4)));
typedef float f32x16 __attribute__((ext_vector_type(16)));
typedef unsigned u32x2 __attribute__((ext_vector_type(2)));
typedef unsigned u32x4 __attribute__((ext_vector_type(4)));
#define LAS __attribute__((address_space(3)))

constexpr int DM = 1024, NB = 2, SEQ = 16384, CTXL = 256, SB = SEQ + CTXL  , NR = NB * SB  , NL = NB * SEQ  ;
constexpr int PW = 2304;
constexpr int NE = 32, TOPK = 4, NASG = NL * TOPK, NPAD = NASG + NE * 256;
constexpr int NCH = SB / 32;
constexpr int NCHAIN = NB * 2 * 8;
constexpr float EPSF = 1e-6f;
constexpr float QSCALE = 0.10206207261596575f * 1.4426950408889634f;
constexpr int NPH = 24;

constexpr size_t al256(size_t x) { return (x + 255) / 256 * 256; }
constexpr size_t WS_CTL   = 0;
constexpr size_t CTL_BYTES = 65536;
constexpr size_t WS_MOD   = WS_CTL + CTL_BYTES;
constexpr size_t WS_ROPE  = WS_MOD + al256(2 * 3 * 6144 * 4);
constexpr size_t WS_TILEP = WS_ROPE + al256(256 * 16 * 4);
constexpr size_t WS_BCNT  = WS_TILEP + 1024;
constexpr size_t WS_WIN   = WS_BCNT + 1024 * 32 * 4;
constexpr size_t WS_WUQ   = WS_WIN + (size_t)PW * 1024 * 2;
constexpr size_t WS_WUKV  = WS_WUQ + 768 * 256 * 2;
constexpr size_t WS_WLORA = WS_WUKV + 1024 * 128 * 2;
constexpr size_t WS_WG2   = WS_WLORA + 2048 * 128 * 2;
constexpr size_t WS_WOUT  = WS_WG2 + 512 * 128 * 2;
constexpr size_t WS_WGMIN = WS_WOUT + 1024 * 1024 * 2;
constexpr size_t WS_WGMOUT= WS_WGMIN + 2048 * 1024 * 2;
constexpr size_t WS_WS    = WS_WGMOUT + 1024 * 1024 * 2;
constexpr size_t WS_WGU   = WS_WS + 1024 * 128 * 2;
constexpr size_t WS_WDN   = WS_WGU + (size_t)2 * 32 * 2048 * 1024 * 2;
constexpr size_t WS_X1    = WS_WDN + (size_t)2 * 32 * 1024 * 1024 * 2;
constexpr size_t WS_HF    = WS_X1 + (size_t)NL * 1024 * 4;
constexpr size_t WS_EIDX  = WS_HF + (size_t)NL * 1024 * 2;
constexpr size_t WS_GATE  = WS_EIDX + (size_t)NL * 4 * 4;
constexpr size_t WS_RTOK  = WS_GATE + (size_t)NL * 4 * 4;
constexpr size_t WS_RGATE = WS_RTOK + al256((size_t)NPAD * 4);
constexpr size_t WS_RSLOT = WS_RGATE + al256((size_t)NPAD * 4);
constexpr size_t WS_ACT   = WS_RSLOT + al256((size_t)NPAD * 4);
constexpr size_t ACT_BYTES = (size_t)NPAD * 1024 * 2;
constexpr size_t WS_YS    = WS_ACT + ACT_BYTES;
constexpr size_t YS_BYTES = (size_t)NASG * 1024 * 2;
constexpr size_t WS_R3    = WS_YS + YS_BYTES;
constexpr size_t WS_P     = WS_ACT;
constexpr size_t WS_H     = WS_P + (size_t)NR * PW * 2;
constexpr size_t WS_RG    = WS_ACT;
constexpr size_t RCH_BYTES = (size_t)NCHAIN * NCH * 4096 * 2;
constexpr size_t WS_RH    = WS_RG + RCH_BYTES;
constexpr size_t WS_YRB   = WS_X1;
constexpr size_t WS_ZS    = WS_X1;
static_assert(WS_H + (size_t)NR * 1024 * 2 <= WS_ACT + ACT_BYTES, "alias");
static_assert(WS_RH + RCH_BYTES <= WS_ACT + ACT_BYTES, "alias");
static_assert(RCH_BYTES <= (size_t)NL * 1024 * 6, "alias ZS on X1|HF");
constexpr size_t WS_LW    = WS_YS;
constexpr size_t WS_AA    = WS_LW + (size_t)NR * 1024 * 2;
static_assert(WS_AA + (size_t)NR * 1024 * 2 <= WS_YS + YS_BYTES, "alias");
constexpr size_t WS_SSQ   = WS_R3;
constexpr size_t WS_Q     = WS_SSQ + (size_t)NR * 8 * 4;
constexpr size_t WS_K     = WS_Q + (size_t)NL * 8 * 96 * 2;
constexpr size_t WS_V     = WS_K + (size_t)NR * 8 * 96 * 2;
constexpr size_t WS_RWR   = WS_V + (size_t)NR * 8 * 64 * 2;
constexpr size_t RW_BYTES = (size_t)NR * 512 * 2;
constexpr size_t WS_RWK   = WS_RWR + RW_BYTES;
constexpr size_t WS_RWV   = WS_RWK + RW_BYTES;
constexpr size_t WS_RWKK  = WS_RWV + RW_BYTES;
constexpr size_t WS_LA    = WS_RWKK + RW_BYTES;
constexpr size_t WS_GA    = WS_LA + (size_t)NR * 128 * 2;
constexpr size_t WS_GG    = WS_GA + (size_t)NR * 128 * 2;
constexpr size_t WS_RRH   = WS_GG + RW_BYTES;
constexpr size_t WS_RY0   = WS_RRH + RCH_BYTES / 2;
constexpr size_t WS_YR    = WS_RY0 + RCH_BYTES / 2;
constexpr size_t WS_MIX   = WS_YR + (size_t)NL * 512 * 4;
constexpr size_t WS_Y     = WS_MIX + (size_t)NL * 1024 * 2;
constexpr size_t WS_GGRP  = WS_Y + (size_t)NL * 1024 * 2;
constexpr size_t GRP_BYTES = (size_t)NCHAIN * (NCH / 20) * 8192;
constexpr size_t WS_HGRP  = WS_GGRP + GRP_BYTES;
constexpr size_t WS_ZGRP  = WS_HGRP + GRP_BYTES;
constexpr size_t WS_END0  = WS_ZGRP + GRP_BYTES;
constexpr size_t WS_U     = WS_Q;
constexpr size_t WS_V1    = WS_U + (size_t)NL * 1024 * 2;
constexpr size_t WS_VT    = WS_V1 + (size_t)NL * 1024 * 2;
constexpr size_t WS_UV    = WS_VT + (size_t)NL * 1024 * 2;
static_assert(WS_UV + (size_t)NL * 1024 * 2 <= WS_MIX, "alias");
constexpr size_t WS_END = WS_END0;
static_assert(WS_END <= (size_t)2147483648ull, "workspace budget (4 x largest tensor)");

typedef __bf16 bf16x2_t __attribute__((ext_vector_type(2)));
__device__ __forceinline__ unsigned cvt_pk_bf16(float lo, float hi) { const f32x2 v = {lo, hi}; return __builtin_bit_cast(unsigned, __builtin_convertvector(v, bf16x2_t)); }
__device__ __forceinline__ float bflo(unsigned w) { return __uint_as_float(w << 16); }
__device__ __forceinline__ float bfhi(unsigned w) { return __uint_as_float(w & 0xffff0000u); }
__device__ __forceinline__ float bf2f(bf16_t b) { return __uint_as_float(((unsigned)b) << 16); }
__device__ __forceinline__ bf16_t f2bf(float f) { return (bf16_t)(cvt_pk_bf16(f, 0.f) & 0xffffu); }
__device__ __forceinline__ void unpack8(u32x4 w, float (&f)[8]) { f[0] = bflo(w.x); f[1] = bfhi(w.x); f[2] = bflo(w.y); f[3] = bfhi(w.y); f[4] = bflo(w.z); f[5] = bfhi(w.z); f[6] = bflo(w.w); f[7] = bfhi(w.w); }
__device__ __forceinline__ u32x4 pack8(const float (&f)[8]) { u32x4 w; w.x = cvt_pk_bf16(f[0], f[1]); w.y = cvt_pk_bf16(f[2], f[3]); w.z = cvt_pk_bf16(f[4], f[5]); w.w = cvt_pk_bf16(f[6], f[7]); return w; }
__device__ __forceinline__ u32x2 pack8_fp8(const float (&f)[8], float sc) { u32x2 w; unsigned a = 0u, b = 0u;
    a = __builtin_amdgcn_cvt_pk_fp8_f32(f[0] * sc, f[1] * sc, a, false); a = __builtin_amdgcn_cvt_pk_fp8_f32(f[2] * sc, f[3] * sc, a, true);
    b = __builtin_amdgcn_cvt_pk_fp8_f32(f[4] * sc, f[5] * sc, b, false); b = __builtin_amdgcn_cvt_pk_fp8_f32(f[6] * sc, f[7] * sc, b, true); w.x = a; w.y = b; return w; }
__device__ __forceinline__ u32x2 pack8_fp8_sat(const float (&f)[8], float sc) { float g[8];
#pragma unroll
    for (int i = 0; i < 8; ++i) g[i] = __builtin_amdgcn_fmed3f(f[i] * sc, -448.0f, 448.0f);
    return pack8_fp8(g, 1.0f); }
__device__ __forceinline__ void unpack8_fp8(u32x2 w, float (&f)[8]) { f32x2 t; t = __builtin_amdgcn_cvt_pk_f32_fp8(w.x, false); f[0] = t.x; f[1] = t.y; t = __builtin_amdgcn_cvt_pk_f32_fp8(w.x, true); f[2] = t.x; f[3] = t.y;
    t = __builtin_amdgcn_cvt_pk_f32_fp8(w.y, false); f[4] = t.x; f[5] = t.y; t = __builtin_amdgcn_cvt_pk_f32_fp8(w.y, true); f[6] = t.x; f[7] = t.y; }
constexpr float FP8_Y_SCALE = 16.0f;
constexpr float FP8_ACT_SCALE = 4.0f, FP8_W_SCALE = 64.0f, FP8_INV = 1.0f / 256.0f;
__device__ __forceinline__ float wave_sum(float v) { v += __shfl_xor(v, 32); v += __shfl_xor(v, 16); v += __shfl_xor(v, 8); v += __shfl_xor(v, 4); v += __shfl_xor(v, 2); v += __shfl_xor(v, 1); return v; }
__device__ __forceinline__ float sigmoidf_(float x) { return __builtin_amdgcn_rcpf(1.0f + __expf(-x)); }

#define XB_TMO      128
#define XB_XCNT(j)  (256  + 64 * (j))
#define XB_XSUB(j)  (1280 + 64 * (j))
#define XB_XGEN(j)  (2304 + 64 * (j))
#define XB_TOP      3328
#define XB_TOPGEN   3392
#define XCD_BAR_WORDS 3456
#define XB_SPIN_CAP (1u << 22)
__device__ __forceinline__ unsigned xb_ld(unsigned* p)              { return __hip_atomic_load(p, __ATOMIC_RELAXED, __HIP_MEMORY_SCOPE_AGENT); }
__device__ __forceinline__ unsigned xb_add(unsigned* p, unsigned v) { return __hip_atomic_fetch_add(p, v, __ATOMIC_RELAXED, __HIP_MEMORY_SCOPE_AGENT); }
__device__ __forceinline__ unsigned xb_xcc_id() { return (unsigned)__builtin_amdgcn_s_getreg((3 << 11) | 20) & 0xFu; }
#define XB_SPIN(cond, bar) do { unsigned _sp = 0; while (cond) { __builtin_amdgcn_s_sleep(1); \
    if ((++_sp & 255u) == 0u) { if (xb_ld(&(bar)[XB_TMO])) break; if (_sp > XB_SPIN_CAP) { atomicAdd(&(bar)[XB_TMO], 1u); break; } } } } while (0)
struct XcdBarrier { unsigned* bar; unsigned x; volatile LAS unsigned* st; };
__device__ __forceinline__ XcdBarrier xcd_barrier_post(unsigned* bar, volatile LAS unsigned* st) {
    XcdBarrier b; b.bar = bar; b.x = xb_xcc_id(); b.st = st;
    if (threadIdx.x == 0) (void)xb_add(&bar[XB_XCNT(b.x)], 1u);
    return b;
}
__device__ __forceinline__ void xcd_barrier_complete(unsigned* bar, unsigned x, unsigned& nloc, unsigned& nx) {
    const unsigned G = gridDim.x * gridDim.y * gridDim.z;
    unsigned sum, cnt, mine, sp = 0u;
    for (;;) {
        sum = 0u; cnt = 0u; mine = 0u;
#pragma unroll
        for (unsigned j = 0; j < 16; ++j) { const unsigned c = xb_ld(&bar[XB_XCNT(j)]); sum += c; cnt += (c > 0u) ? 1u : 0u; mine = (j == x) ? c : mine; }
        if (sum == G) break;
        __builtin_amdgcn_s_sleep(1);
        if ((++sp & 255u) == 0u) { if (xb_ld(&bar[XB_TMO])) break; if (sp > XB_SPIN_CAP) { atomicAdd(&bar[XB_TMO], 1u); break; } }
    }
    nloc = mine > 0u ? mine : 1u; nx = cnt > 0u ? cnt : 1u;
}
__device__ __forceinline__ void xcd_barrier(const XcdBarrier& b) {
    asm volatile("s_waitcnt vmcnt(0)" ::: "memory");
    __syncthreads();
    if (threadIdx.x == 0) {
        unsigned* bar = b.bar;
        __builtin_amdgcn_s_waitcnt(0);
        unsigned nloc = b.st[0], nx = b.st[1];
        if (nloc == 0u) { xcd_barrier_complete(bar, b.x, nloc, nx); b.st[0] = nloc; b.st[1] = nx; }
        const unsigned old = xb_add(&bar[XB_XSUB(b.x)], 1u);
        const unsigned gen = old / nloc;
        if (old + 1u == (gen + 1u) * nloc) {
            __builtin_amdgcn_fence(__ATOMIC_RELEASE, "agent");
            asm volatile("s_waitcnt vmcnt(0)" ::: "memory");
            const unsigned og = xb_add(&bar[XB_TOP], 1u);
            const unsigned tg = og / nx;
            if (og + 1u == (tg + 1u) * nx) xb_add(&bar[XB_TOPGEN], 1u);
            else XB_SPIN(xb_ld(&bar[XB_TOPGEN]) == tg, bar);
            __builtin_amdgcn_fence(__ATOMIC_ACQUIRE, "agent");
            xb_add(&bar[XB_XGEN(b.x)], 1u);
            asm volatile("s_waitcnt vmcnt(0)" ::: "memory");
        } else {
            XB_SPIN(xb_ld(&bar[XB_XGEN(b.x)]) == gen, bar);
            __builtin_amdgcn_fence(__ATOMIC_ACQUIRE, "agent");
            asm volatile("s_waitcnt vmcnt(0)" ::: "memory");
        }
    }
    __syncthreads();
}

struct Args { const float* in[40]; float* out; unsigned char* ws; int ph_lo, ph_hi; };
enum { I_X = 0, I_C, I_CTX, I_CCTX, I_ADAW, I_ADAB, I_NMPRE, I_NMPOST, I_NFPRE, I_NFPOST, I_RW, I_RB, I_WGU, I_BGU, I_WDN, I_BDN,
       I_WIN, I_QNORM, I_WUQ, I_KVNORM, I_WUKV, I_MUP, I_MUN, I_W0, I_W2, I_A0, I_A2, I_G2, I_KK, I_KA, I_RK, I_LNW, I_LNB, I_WOUT,
       I_GMIN, I_GMVW, I_GMVB, I_GMWS, I_GMBS, I_GMOUT };
namespace pg8 {
constexpr int BM = 256, BK = 64, HALF = 128, HTB = HALF * BK * 2, STAGE_BYTES = 8 * HTB, NXCD = 8, WGM = 8;
__host__ __device__ __forceinline__ int lds_byte(int r, int c) { const int st = (r >> 4) * 2 + (c >> 5), rr = r & 15, cc = c & 31, ob = rr * 64 + cc * 2; return st * 1024 + (ob ^ (((ob >> 9) & 1) << 5)); }
__host__ __device__ __forceinline__ void stage_rc(int b, int& R, int& C) { const int st = b / 1024, sb = b % 1024, swz = sb ^ (((sb >> 9) & 1) << 5); R = (st >> 1) * 16 + swz / 64; C = (st & 1) * 32 + (swz % 64) / 2; }
__host__ __device__ __forceinline__ int perm32(int rho) { const int n = rho >> 4, i = rho & 15; return 8 * (i >> 2) + 4 * n + (i & 3); }

struct Unit { int pm, pn, a0, a1, par; };
template <class E> __device__ __forceinline__ void prestage(const E&, const Unit&, int, int) {}
struct Gemm { const bf16_t* A; const bf16_t* Bt; int lda, ldb, K; };

__device__ __forceinline__ bool tile_order(long L, int nM, int nN, int& pm, int& pn) {
    const int nwg = nM * nN; if (L >= nwg) return false;
    int wgid = (int)L; { const int q = nwg / NXCD, r = nwg % NXCD, xcd = wgid % NXCD, off = wgid / NXCD; wgid = (xcd < r ? xcd * (q + 1) : r * (q + 1) + (xcd - r) * q) + off; }
    const int nig = WGM * nN, gid = wgid / nig, fm = gid * WGM, gsz = (nM - fm) < WGM ? (nM - fm) : WGM;
    pm = fm + ((wgid % nig) % gsz); pn = (wgid % nig) / gsz; return true;
}
struct StaticOrder {
    static constexpr bool GATHER = false;
    int nM, nN, G, c, skipctx;
    __device__ void init(int M, int N, int G_, int c_, int skipctx_ = 0) { nM = M / BM; nN = N / BM; G = G_; c = c_; skipctx = skipctx_; if (skipctx) nM -= 2; }
    __device__ bool next(int i, Unit& u) const {
        int pm, pn; if (!tile_order((long)i * G + c, nM, nN, pm, pn)) return false;
        if (skipctx) pm = pm + 1 + (pm >= 64 ? 1 : 0);
        u.pm = pm; u.pn = pn; u.a0 = 0; u.a1 = 0; return true;
    }
    __device__ __forceinline__ const char* a_ptr(const Gemm& g, const Unit& u) const { return (const char*)g.A + (size_t)u.pm * BM * g.lda * 2; }
    __device__ __forceinline__ const char* b_ptr(const Gemm& g, const Unit& u) const { return (const char*)g.Bt + (size_t)u.pn * BM * g.ldb * 2; }
    __device__ __forceinline__ unsigned gather(const Unit&, int, int) const { return 0u; }
    __device__ __forceinline__ unsigned gather_raw(const Unit&, int) const { return 0u; }
};
struct SpatialOrder {
    static constexpr bool GATHER = false;
    int G, c;
    __device__ bool next(int i, Unit& u) const { const long L = (long)i * G + c; if (L >= 1024) return false; u.pm = (int)(L & 3); u.pn = (int)L; u.a0 = (int)(L >> 2); u.a1 = 0; return true; }
    __device__ __forceinline__ const char* a_ptr(const Gemm& g, const Unit& u) const { return (const char*)g.A + (size_t)u.pm * BM * g.lda * 2; }
    __device__ __forceinline__ const char* b_ptr(const Gemm& g, const Unit& u) const { return (const char*)g.Bt + (size_t)u.pn * BM * g.ldb * 2; }
    __device__ __forceinline__ unsigned gather(const Unit&, int, int) const { return 0u; }
    __device__ __forceinline__ unsigned gather_raw(const Unit&, int) const { return 0u; }
};
template <bool GATHER_, int NN, int WSTRIDE  > struct MoeOrder {
    static constexpr bool GATHER = GATHER_;
    int G, c; LAS unsigned char* tab; const int* rowtok;
    __device__ bool next(int i, Unit& u) const {
        const LAS int* tpfx = (const LAS int*)(tab + 256); const LAS int* cnt = (const LAS int*)(tab + 512); const LAS unsigned char* t2e = tab + 768;
        const int T = tpfx[32]; int pm, pn; if (!tile_order((long)i * G + c, T, NN, pm, pn)) return false;
        const int e = t2e[pm];
        u.pm = pm; u.pn = pn; u.a0 = e; const int left = cnt[e] - (pm - tpfx[e]) * 256; u.a1 = left < 256 ? left : 256; return true;
    }
    __device__ __forceinline__ const char* a_ptr(const Gemm& g, const Unit& u) const { return GATHER ? (const char*)g.A : (const char*)g.A + (size_t)u.pm * BM * g.lda * 2; }
    __device__ __forceinline__ const char* b_ptr(const Gemm& g, const Unit& u) const { return (const char*)g.Bt + (size_t)u.a0 * WSTRIDE + (size_t)u.pn * BM * g.ldb * 2; }
    __device__ __forceinline__ unsigned gather(const Unit& u, int rowInTile, int lda) const { return (unsigned)rowtok[u.pm * 256 + rowInTile] * (unsigned)lda * 2u; }
    __device__ __forceinline__ unsigned gather_raw(const Unit& u, int rowInTile) const { unsigned v; const int* p = rowtok + u.pm * 256 + rowInTile;
        asm volatile("global_load_dword %0, %1, off" : "=v"(v) : "v"(p) : "memory"); return v; }
};

template <class Epi, class Sched, bool FP8 = false>
__device__ __forceinline__ void gemm_phase(LAS unsigned char* lds, const Gemm g, const Sched& S, const Epi& E, const int tid) {
    const int wid = __builtin_amdgcn_readfirstlane(tid >> 6), lane = tid & 63, wr = wid >> 2, wc = wid & 3, fr = lane & 15, fq = lane >> 4;
    int K = g.K; asm volatile("" : "+s"(K));
    const int nt = K / BK;
    unsigned voffA[2][2], voffN[2][2], voffB[2]; int RA[2], CA[2];
#pragma unroll
    for (int i = 0; i < 2; ++i) { int R, C; stage_rc(tid * 16 + i * 8192, R, C); const int Rb = (R & ~31) + perm32(R & 31);
        RA[i] = R; CA[i] = C; voffB[i] = (unsigned)(Rb * g.ldb + C) * 2u;
        voffA[0][i] = (unsigned)(R * g.lda + C) * 2u; voffA[1][i] = (unsigned)((R + HALF) * g.lda + C) * 2u; voffN[0][i] = voffA[0][i]; voffN[1][i] = voffA[1][i]; }
    const size_t kstep = (size_t)(BK * 2);
    const size_t hstepB = (size_t)HALF * g.ldb * 2;
    const unsigned ldsw = (unsigned)wid * 1024u;
    const int aoff = lds_byte(wr * 64 + fr, fq * 8), boff = lds_byte(wc * 32 + fr, fq * 8);
#define PG8_SA(b, h) (((b) * 2 + (h)) * HTB)
#define PG8_SB(b, h) ((4 + (b) * 2 + (h)) * HTB)
#define PG8_STAGE(bufoff, gbase, voff) do { _Pragma("unroll") for (int _i = 0; _i < 2; ++_i) \
        __builtin_amdgcn_global_load_lds((const unsigned*)((const char*)(gbase) + (voff)[_i]), (LAS unsigned*)(lds + (bufoff) + ldsw + _i * 8192), 16, 0, 0); } while (0)
#define PG8_LDA(dst, b, h) do { _Pragma("unroll") for (int m = 0; m < 4; ++m) { const i32x4_ lo_ = *(const LAS i32x4_*)(lds + PG8_SA(b, h) + aoff + m * 2048), hi_ = *(const LAS i32x4_*)(lds + PG8_SA(b, h) + aoff + m * 2048 + 1024); \
        dst[m] = __builtin_shufflevector(lo_, hi_, 0, 1, 2, 3, 4, 5, 6, 7); } } while (0)
#define PG8_LDB(dst, b, h) do { _Pragma("unroll") for (int n = 0; n < 2; ++n) { const i32x4_ lo_ = *(const LAS i32x4_*)(lds + PG8_SB(b, h) + boff + n * 2048), hi_ = *(const LAS i32x4_*)(lds + PG8_SB(b, h) + boff + n * 2048 + 1024); \
        dst[n] = __builtin_shufflevector(lo_, hi_, 0, 1, 2, 3, 4, 5, 6, 7); } } while (0)
#define PG8_MMA(ai, bj, At, Bt) do { __builtin_amdgcn_s_setprio(1); _Pragma("unroll") for (int m = 0; m < 4; ++m) _Pragma("unroll") for (int n = 0; n < 2; ++n) { \
        if constexpr (FP8) asm volatile("v_mfma_f32_16x16x128_f8f6f4 %0, %1, %2, %0" : "+v"(acc[ai][bj][m][n]) : "v"(Bt[n]), "v"(At[m]));     \
        else { const i32x4_ b0_ = __builtin_shufflevector(Bt[n], Bt[n], 0, 1, 2, 3), b1_ = __builtin_shufflevector(Bt[n], Bt[n], 4, 5, 6, 7), a0_ = __builtin_shufflevector(At[m], At[m], 0, 1, 2, 3), a1_ = __builtin_shufflevector(At[m], At[m], 4, 5, 6, 7); \
            acc[ai][bj][m][n] = __builtin_amdgcn_mfma_f32_16x16x32_bf16(*(const bf16x8*)&b0_, *(const bf16x8*)&a0_, acc[ai][bj][m][n], 0, 0, 0); \
            acc[ai][bj][m][n] = __builtin_amdgcn_mfma_f32_16x16x32_bf16(*(const bf16x8*)&b1_, *(const bf16x8*)&a1_, acc[ai][bj][m][n], 0, 0, 0); } } \
        __builtin_amdgcn_s_setprio(0); } while (0)
#define PG8_WAIT_V(n) asm volatile("s_waitcnt vmcnt(" #n ")" ::: "memory")
#define PG8_WAIT_L(n) asm volatile("s_waitcnt lgkmcnt(" #n ")" ::: "memory")
#define PG8_BAR __builtin_amdgcn_s_barrier()
#define PG8_SCHED __builtin_amdgcn_sched_barrier(0)
    Unit cur, nxt; int ui = 0;
    if (!S.next(0, cur)) return;
    f32x4 acc[2][2][4][2];
#pragma unroll
    for (int a = 0; a < 2; ++a)
#pragma unroll
        for (int b = 0; b < 2; ++b)
#pragma unroll
            for (int m = 0; m < 4; ++m)
#pragma unroll
                for (int n = 0; n < 2; ++n) acc[a][b][m][n] = (f32x4){0.f, 0.f, 0.f, 0.f};
    typedef int i32x8_ __attribute__((ext_vector_type(8))); typedef int i32x4_ __attribute__((ext_vector_type(4)));
    i32x8_ At[4], B0[2], B1[2];
    const char* cA = S.a_ptr(g, cur); const char* cB = S.b_ptr(g, cur);
    cur.par = 0; prestage(E, cur, wid, lane);
    if constexpr (Sched::GATHER) {
#pragma unroll
        for (int h = 0; h < 2; ++h)
#pragma unroll
            for (int i = 0; i < 2; ++i) voffA[h][i] = S.gather(cur, h * HALF + RA[i], g.lda) + (unsigned)CA[i] * 2u;
    }
    PG8_STAGE(PG8_SB(0, 0), cB, voffB); PG8_STAGE(PG8_SA(0, 0), cA, voffA[0]); PG8_STAGE(PG8_SB(0, 1), cB + hstepB, voffB); PG8_STAGE(PG8_SA(0, 1), cA, voffA[1]);
    if (wr == 1) PG8_BAR;
    PG8_WAIT_V(4); PG8_BAR;
    PG8_STAGE(PG8_SB(1, 0), cB + kstep, voffB); PG8_STAGE(PG8_SA(1, 0), cA + kstep, voffA[0]); PG8_STAGE(PG8_SB(1, 1), cB + hstepB + kstep, voffB);
    PG8_WAIT_V(6); PG8_BAR;
    for (;;) {
        const bool has_next = S.next(ui + 1, nxt);
        const char* nA = has_next ? S.a_ptr(g, nxt) : cA; const char* nB = has_next ? S.b_ptr(g, nxt) : cB;
        unsigned rawN[2][2];
        if constexpr (Sched::GATHER) {
            if (has_next) {
#pragma unroll
                for (int h = 0; h < 2; ++h)
#pragma unroll
                    for (int i = 0; i < 2; ++i) rawN[h][i] = S.gather_raw(nxt, h * HALF + RA[i]);
            }
        }
        for (int t = 0; t < nt; t += 2) {
            const bool last = (t == nt - 2);
            if constexpr (Sched::GATHER) { if (last) {
                if (has_next) {
#pragma unroll
                    for (int h = 0; h < 2; ++h)
#pragma unroll
                        for (int i = 0; i < 2; ++i) { unsigned r_ = rawN[h][i]; asm volatile("" : "+v"(r_)); voffN[h][i] = r_ * (unsigned)g.lda * 2u + (unsigned)CA[i] * 2u; }
                } else {
#pragma unroll
                    for (int h = 0; h < 2; ++h)
#pragma unroll
                        for (int i = 0; i < 2; ++i) voffN[h][i] = voffA[h][i];
                } } }
            const char* a1 = cA + (size_t)(t + 1) * kstep;
            const char* a2 = last ? nA : cA + (size_t)(t + 2) * kstep; const char* b2 = last ? nB : cB + (size_t)(t + 2) * kstep;
            const char* a3 = a2 + kstep; const char* b3 = b2 + kstep;
            unsigned v2[2][2];
#pragma unroll
            for (int h = 0; h < 2; ++h)
#pragma unroll
                for (int i = 0; i < 2; ++i) v2[h][i] = (Sched::GATHER && last) ? voffN[h][i] : voffA[h][i];
            PG8_LDB(B0, 0, 0); PG8_SCHED; PG8_LDA(At, 0, 0); PG8_STAGE(PG8_SA(1, 1), a1, voffA[1]);
            PG8_WAIT_L(8); PG8_BAR; PG8_WAIT_L(0); PG8_MMA(0, 0, At, B0); PG8_BAR; PG8_SCHED;
            PG8_LDB(B1, 0, 1); PG8_STAGE(PG8_SB(0, 0), b2, voffB);
            PG8_BAR; PG8_WAIT_L(0); PG8_MMA(0, 1, At, B1); PG8_BAR;
            PG8_LDA(At, 0, 1); PG8_STAGE(PG8_SA(0, 0), a2, v2[0]);
            PG8_BAR; PG8_WAIT_L(0); PG8_MMA(1, 0, At, B0); PG8_BAR; PG8_SCHED;
            PG8_STAGE(PG8_SB(0, 1), b2 + hstepB, voffB);
            PG8_WAIT_V(6); PG8_BAR; PG8_MMA(1, 1, At, B1); PG8_BAR;
            PG8_LDB(B0, 1, 0); PG8_SCHED; PG8_LDA(At, 1, 0); PG8_STAGE(PG8_SA(0, 1), a2, v2[1]);
            PG8_WAIT_L(8); PG8_BAR; PG8_WAIT_L(0); PG8_MMA(0, 0, At, B0); PG8_BAR; PG8_SCHED;
            PG8_LDB(B1, 1, 1); PG8_STAGE(PG8_SB(1, 0), b3, voffB);
            PG8_BAR; PG8_WAIT_L(0); PG8_MMA(0, 1, At, B1); PG8_BAR;
            PG8_LDA(At, 1, 1); PG8_STAGE(PG8_SA(1, 0), a3, v2[0]);
            PG8_BAR; PG8_WAIT_L(0); PG8_MMA(1, 0, At, B0); PG8_BAR; PG8_SCHED;
            PG8_STAGE(PG8_SB(1, 1), b3 + hstepB, voffB);
            PG8_WAIT_V(6); PG8_BAR; PG8_MMA(1, 1, At, B1); PG8_BAR;
        }
        if constexpr (FP8) asm volatile("s_nop 15\n\ts_nop 15" ::: "memory");
        { int fr2 = fr, fq2 = fq; asm volatile("" : "+v"(fr2), "+v"(fq2));
          E(acc, cur, wr, wc, fr2, fq2); }
        if (!has_next) break;
#pragma unroll
        for (int a = 0; a < 2; ++a)
#pragma unroll
            for (int b = 0; b < 2; ++b)
#pragma unroll
                for (int m = 0; m < 4; ++m)
#pragma unroll
                    for (int n = 0; n < 2; ++n) acc[a][b][m][n] = (f32x4){0.f, 0.f, 0.f, 0.f};
        cur = nxt; cA = nA; cB = nB; ++ui; cur.par = ui & 1; prestage(E, cur, wid, lane);
        if constexpr (Sched::GATHER) {
#pragma unroll
            for (int h = 0; h < 2; ++h)
#pragma unroll
                for (int i = 0; i < 2; ++i) voffA[h][i] = voffN[h][i];
        }
    }
    PG8_WAIT_V(0);
    if (wr == 0) PG8_BAR;
    PG8_BAR;
#undef PG8_SA
#undef PG8_SB
#undef PG8_STAGE
#undef PG8_LDA
#undef PG8_LDB
#undef PG8_MMA
#undef PG8_WAIT_V
#undef PG8_WAIT_L
#undef PG8_BAR
#undef PG8_SCHED
}
}
namespace epi {
using pg8::Unit;
typedef f32x4 Acc[2][2][4][2];

__device__ __forceinline__ f32x2 gelu_pk(f32x2 v) {
    const f32x2 av = __builtin_elementwise_abs(v), d = av * 0.2316418882f + 1.0f;
    f32x2 t; t.x = __builtin_amdgcn_rcpf(d.x); t.y = __builtin_amdgcn_rcpf(d.y);
    f32x2 q = t * 0.5307027145f + (-0.7265760135f); q = q * t + 0.7107068705f; q = q * t + (-0.142248368f); q = q * t + 0.127414796f; q = q * t;
    const f32x2 s = (v * v) * (-0.72134752044f);
    f32x2 e; e.x = __builtin_amdgcn_exp2f(s.x); e.y = __builtin_amdgcn_exp2f(s.y);
    const f32x2 m = v * (q * e), r = v - m;
    f32x2 o; o.x = v.x < 0.f ? m.x : r.x; o.y = v.y < 0.f ? m.y : r.y; return o;
}

template <int ACT, int SC = 0> struct Bf16Out {
    bf16_t* O; int ldc; int split_cols; size_t split_stride;
    __device__ __forceinline__ void operator()(const Acc& acc, const Unit& u, int wr, int wc, int fr, int fq) const {
        const int row0 = u.pm * 256 + wr * 64 + fr; int colt = u.pn * 256; bf16_t* base = O;
        if (split_cols) { const int t = colt / split_cols; base += (size_t)t * split_stride; colt -= t * split_cols; }
        const int col0 = colt + wc * 32 + 8 * fq;
#pragma unroll
        for (int ai = 0; ai < 2; ++ai)
#pragma unroll
            for (int m = 0; m < 4; ++m) { bf16_t* rowp = base + (size_t)(row0 + ai * 128 + m * 16) * ldc + col0;
#pragma unroll
                for (int bj = 0; bj < 2; ++bj) { f32x4 v0 = acc[ai][bj][m][0], v1 = acc[ai][bj][m][1];
                    if (SC) { v0 *= FP8_INV; v1 *= FP8_INV; }
                    if (ACT == 1) { f32x2 a = gelu_pk((f32x2){v0[0], v0[1]}), b = gelu_pk((f32x2){v0[2], v0[3]}), c = gelu_pk((f32x2){v1[0], v1[1]}), d = gelu_pk((f32x2){v1[2], v1[3]});
                        v0 = (f32x4){a.x, a.y, b.x, b.y}; v1 = (f32x4){c.x, c.y, d.x, d.y}; }
                    u32x4 w; w.x = cvt_pk_bf16(v0[0], v0[1]); w.y = cvt_pk_bf16(v0[2], v0[3]); w.z = cvt_pk_bf16(v1[0], v1[1]); w.w = cvt_pk_bf16(v1[2], v1[3]);
                    *(u32x4*)(rowp + bj * 128) = w; } }
    }
};

struct POut {
    bf16_t* P; float* ssq;
    __device__ __forceinline__ void operator()(const Acc& acc, const Unit& u, int wr, int wc, int fr, int fq) const {
        const int row0 = u.pm * 256 + wr * 64 + fr, col0 = u.pn * 256 + wc * 32 + 8 * fq;
#pragma unroll
        for (int ai = 0; ai < 2; ++ai)
#pragma unroll
            for (int m = 0; m < 4; ++m) { const int row = row0 + ai * 128 + m * 16; bf16_t* rowp = P + (size_t)row * PW + col0; float s0 = 0.f, s1 = 0.f;
#pragma unroll
                for (int bj = 0; bj < 2; ++bj) { const f32x4 v0 = acc[ai][bj][m][0], v1 = acc[ai][bj][m][1];
                    u32x4 w; w.x = cvt_pk_bf16(v0[0], v0[1]); w.y = cvt_pk_bf16(v0[2], v0[3]); w.z = cvt_pk_bf16(v1[0], v1[1]); w.w = cvt_pk_bf16(v1[2], v1[3]);
                    *(u32x4*)(rowp + bj * 128) = w;
                    const float s = v0[0] * v0[0] + v0[1] * v0[1] + v0[2] * v0[2] + v0[3] * v0[3] + v1[0] * v1[0] + v1[1] * v1[1] + v1[2] * v1[2] + v1[3] * v1[3];
                    if (bj == 0) s0 = s; else s1 = s; }
                if (u.pn <= 1) {
                    float s = (u.pn == 0) ? (s0 + s1) : s0;
                    s += __shfl_xor(s, 16); s += __shfl_xor(s, 32);
                    if (fq == 0) ssq[(size_t)row * 8 + (u.pn == 0 ? 0 : 4) + wc] = s;
                } }
    }
};

struct QOut {
    bf16_t* Q; const float* ssq; const float* rope;
    __device__ __forceinline__ void operator()(const Acc& acc, const Unit& u, int wr, int wc, int fr, int fq) const {
        f32x4 sq8[8];
#pragma unroll
        for (int q = 0; q < 8; ++q) sq8[q] = *(const f32x4*)(ssq + (size_t)(u.pm * 256 + (q >> 2) * 128 + wr * 64 + (q & 3) * 16 + fr) * 8);
#pragma unroll
        for (int ai = 0; ai < 2; ++ai)
#pragma unroll
            for (int m = 0; m < 4; ++m) {
                const int row = u.pm * 256 + ai * 128 + wr * 64 + m * 16 + fr; const int b = row / SB, t = row - b * SB - CTXL;
                const f32x4 sq = sq8[ai * 4 + m];
                const float rstd = __builtin_amdgcn_rsqf((sq[0] + sq[1] + sq[2] + sq[3]) * (1.0f / 256.0f) + EPSF) * QSCALE;
#pragma unroll
                for (int bj = 0; bj < 2; ++bj) {
                    const int g32 = u.pn * 8 + bj * 4 + wc; const int c8 = g32 * 32 + 8 * fq; const int head = c8 / 96, d8 = c8 - head * 96;
                    float v[8];
#pragma unroll
                    for (int j = 0; j < 4; ++j) { v[j] = acc[ai][bj][m][0][j] * rstd; v[4 + j] = acc[ai][bj][m][1][j] * rstd; }
                    if (g32 % 3 == 2) {
                        const int axis = fq >> 1, half = fq & 1; const int pos = axis ? (t & 63) : (t >> 6);
                        const float* tb = rope + pos * 16;
#pragma unroll
                        for (int j = 0; j < 8; ++j) { const float pv = __shfl_xor(v[j], 16); const float cs = tb[2 * j], sn = tb[2 * j + 1];
                            v[j] = half ? (v[j] * cs + pv * sn) : (v[j] * cs - pv * sn); }
                    }
                    *(u32x4*)(Q + ((size_t)(b * 8 + head) * SEQ + t) * 96 + d8) = pack8(v);
                } }
    }
};

struct KVOut {
    bf16_t* Kb; bf16_t* Vb; const float* ssq;
    __device__ __forceinline__ void operator()(const Acc& acc, const Unit& u, int wr, int wc, int fr, int fq) const {
        f32x4 sq8[8];
#pragma unroll
        for (int q = 0; q < 8; ++q) sq8[q] = *(const f32x4*)(ssq + (size_t)(u.pm * 256 + (q >> 2) * 128 + wr * 64 + (q & 3) * 16 + fr) * 8 + 4);
#pragma unroll
        for (int ai = 0; ai < 2; ++ai)
#pragma unroll
            for (int m = 0; m < 4; ++m) {
                const int row = u.pm * 256 + ai * 128 + wr * 64 + m * 16 + fr; const int b = row / SB, n = row - b * SB;
                const f32x4 sq = sq8[ai * 4 + m];
                const float rstd = __builtin_amdgcn_rsqf((sq[0] + sq[1] + sq[2] + sq[3]) * (1.0f / 128.0f) + EPSF);
#pragma unroll
                for (int bj = 0; bj < 2; ++bj) {
                    const int head = u.pn * 2 + bj, d8 = wc * 32 + 8 * fq;
                    float v[8];
#pragma unroll
                    for (int j = 0; j < 4; ++j) { v[j] = acc[ai][bj][m][0][j] * rstd; v[4 + j] = acc[ai][bj][m][1][j] * rstd; }
                    const size_t hr = (size_t)(b * 8 + head) * SB + n;
                    if (d8 < 64) *(u32x4*)(Kb + hr * 96 + d8) = pack8(v); else *(u32x4*)(Vb + hr * 64 + (d8 - 64)) = pack8(v);
                } }
    }
};

struct LoraOut {
    bf16_t* LW; bf16_t* AA; const float* w0; const float* a0;
    __device__ __forceinline__ void operator()(const Acc& acc, const Unit& u, int wr, int wc, int fr, int fq) const {
        const int which = u.pn >> 1, d = which & 1;
        const float* bias_ = (which < 2 ? w0 : a0) + d * 512 + (u.pn & 1) * 256 + wc * 32 + 8 * fq;
        const f32x4 bb[4] = {*(const f32x4*)bias_, *(const f32x4*)(bias_ + 4), *(const f32x4*)(bias_ + 128), *(const f32x4*)(bias_ + 132)};
#pragma unroll
        for (int bj = 0; bj < 2; ++bj) {
            const int ch = (u.pn & 1) * 256 + bj * 128 + wc * 32 + 8 * fq; const int h = ch >> 6, j8 = ch & 63;
            const f32x4 b0 = bb[2 * bj], b1 = bb[2 * bj + 1];
#pragma unroll
            for (int ai = 0; ai < 2; ++ai)
#pragma unroll
                for (int m = 0; m < 4; ++m) {
                    const int row = u.pm * 256 + ai * 128 + wr * 64 + m * 16 + fr; const int b = row / SB, n = row - b * SB;
                    float v[8];
#pragma unroll
                    for (int j = 0; j < 4; ++j) { v[j] = sigmoidf_(acc[ai][bj][m][0][j] + b0[j]); v[4 + j] = sigmoidf_(acc[ai][bj][m][1][j] + b1[j]); }
                    if (which < 2) {
#pragma unroll
                        for (int j = 0; j < 8; ++j) v[j] *= -0.6065306597126334f;
                    }
                    bf16_t* dst = (which < 2 ? LW : AA) + ((size_t)((b * 2 + d) * 8 + h) * SB + n) * 64 + j8;
                    *(u32x4*)dst = pack8(v);
                } }
    }
};

struct SpatialOut {
    const bf16_t* U; unsigned char* UV; const float* bs;
    __device__ __forceinline__ void operator()(const Acc& acc, const Unit& u, int wr, int wc, int fr, int fq) const {
        const int n = u.a0, q = u.pm;
        u32x4 uu4[8]; float bias8[8];
#pragma unroll
        for (int ai = 0; ai < 2; ++ai)
#pragma unroll
            for (int m = 0; m < 4; ++m) { const int g = 2 * q + ai, i = wr * 64 + m * 16 + fr;
                uu4[ai * 4 + m] = *(const u32x4*)(U + (size_t)(n * 128 + i) * 1024 + g * 128 + wc * 32 + 8 * fq); bias8[ai * 4 + m] = bs[g * 128 + i]; }
#pragma unroll
        for (int ai = 0; ai < 2; ++ai) { const int g = 2 * q + ai;
#pragma unroll
            for (int m = 0; m < 4; ++m) { const int i = wr * 64 + m * 16 + fr; const float bias = bias8[ai * 4 + m];
                const size_t off = (size_t)(n * 128 + i) * 1024 + g * 128 + wc * 32 + 8 * fq;
                float uu[8]; unpack8(uu4[ai * 4 + m], uu);
                float v[8];
#pragma unroll
                for (int j = 0; j < 4; ++j) { v[j] = (acc[ai][ai][m][0][j] + bias) * uu[j]; v[4 + j] = (acc[ai][ai][m][1][j] + bias) * uu[4 + j]; }
                *(u32x2*)(UV + off) = pack8_fp8_sat(v, FP8_ACT_SCALE);
            } }
    }
};

struct Moe1Out {
    unsigned char* ACT; const float* bgu; LAS unsigned char* tab;
    __device__ __forceinline__ void operator()(const Acc& acc, const Unit& u, int wr, int wc, int fr, int fq) const {
        const int e = u.a0, nvalid = u.a1; const int gc = u.pn * 128 + wc * 32 + 8 * fq;
        const LAS unsigned char* tb = tab + u.par * 1024 + (wc * 32 + 8 * fq) * 4; (void)e;
        const f32x4 g0 = *(const LAS f32x4*)tb, g1 = *(const LAS f32x4*)(tb + 16), l0 = *(const LAS f32x4*)(tb + 512), l1 = *(const LAS f32x4*)(tb + 528);
#pragma unroll
        for (int ai = 0; ai < 2; ++ai)
#pragma unroll
            for (int m = 0; m < 4; ++m) { const int rl = ai * 128 + wr * 64 + m * 16 + fr;
                float v[8];
#pragma unroll
                for (int j = 0; j < 8; ++j) { const int n = j >> 2, jj = j & 3;
                    float xg = acc[ai][0][m][n][jj] * FP8_INV + (n ? g1[jj] : g0[jj]); float xl = acc[ai][1][m][n][jj] * FP8_INV + (n ? l1[jj] : l0[jj]);
                    xg = fminf(xg, 7.0f); xl = fminf(fmaxf(xl, -7.0f), 7.0f);
                    v[j] = xg * sigmoidf_(1.702f * xg) * (xl + 1.0f); }
                if (rl < nvalid) *(u32x2*)(ACT + (size_t)(u.pm * 256 + rl) * 1024 + gc) = pack8_fp8(v, FP8_ACT_SCALE);
                __builtin_amdgcn_sched_barrier(0);
            }
    }
};
__device__ __forceinline__ void prestage(const Moe1Out& E, const Unit& u, int wid, int lane) {
    if (wid == 0) __builtin_amdgcn_global_load_lds((const unsigned*)(E.bgu + (size_t)u.a0 * 2048 + u.pn * 128 + (lane & 31) * 4 + (lane >> 5) * 1024), (LAS unsigned*)(E.tab + u.par * 1024), 16, 0, 0);
}
struct Moe2Out {
    unsigned char* YS; const float* bdn; const int* rslot; const float* rgate; LAS unsigned char* tab;
    __device__ __forceinline__ void operator()(const Acc& acc, const Unit& u, int wr, int wc, int fr, int fq) const {
        const int nvalid = u.a1; const int col0 = u.pn * 256 + wc * 32 + 8 * fq;
        const LAS unsigned char* tb = tab + u.par * 3072;
        int slot[8]; float gt[8];
#pragma unroll
        for (int q = 0; q < 8; ++q) { const int rl = (q >> 2) * 128 + wr * 64 + (q & 3) * 16 + fr; slot[q] = *(const LAS int*)(tb + rl * 4); gt[q] = *(const LAS float*)(tb + 1024 + rl * 4); }
        const LAS unsigned char* bl = tb + 2048 + (wc * 32 + 8 * fq) * 4;
        const f32x4 bb[4] = {*(const LAS f32x4*)bl, *(const LAS f32x4*)(bl + 16), *(const LAS f32x4*)(bl + 512), *(const LAS f32x4*)(bl + 528)};
#pragma unroll
        for (int bj = 0; bj < 2; ++bj) { const f32x4 b0 = bb[2 * bj], b1 = bb[2 * bj + 1];
#pragma unroll
            for (int ai = 0; ai < 2; ++ai)
#pragma unroll
                for (int m = 0; m < 4; ++m) { const int rl = ai * 128 + wr * 64 + m * 16 + fr; const float g = gt[ai * 4 + m]; float v[8];
#pragma unroll
                    for (int j = 0; j < 4; ++j) { v[j] = (acc[ai][bj][m][0][j] * FP8_INV + b0[j]) * g; v[4 + j] = (acc[ai][bj][m][1][j] * FP8_INV + b1[j]) * g; }
                    if (rl < nvalid) *(u32x2*)(YS + (size_t)slot[ai * 4 + m] * 1024 + col0 + bj * 128) = pack8_fp8_sat(v, FP8_Y_SCALE); } }
    }
};
__device__ __forceinline__ void prestage(const Moe2Out& E, const Unit& u, int wid, int lane) {
    LAS unsigned char* tb = E.tab + u.par * 3072;
    if (wid == 0) __builtin_amdgcn_global_load_lds((const unsigned*)(E.rslot + u.pm * 256 + lane * 4), (LAS unsigned*)tb, 16, 0, 0);
    else if (wid == 1) __builtin_amdgcn_global_load_lds((const unsigned*)(E.rgate + u.pm * 256 + lane * 4), (LAS unsigned*)(tb + 1024), 16, 0, 0);
    else if (wid == 2) __builtin_amdgcn_global_load_lds((const unsigned*)(E.bdn + (size_t)u.a0 * 1024 + u.pn * 256 + lane * 4), (LAS unsigned*)(tb + 2048), 16, 0, 0);
}
}
namespace att {
constexpr int DQ = 96, DV = 64, NW = 8, QBLK = 32, KVBLK = 64;
constexpr int SHM_V = KVBLK * DV * 2  , SHM_K = KVBLK * 256  , SHM_ATTN = 3 * SHM_V + 2 * SHM_K + NW * 64 * 4;
constexpr float THR2 = 10.0f;
#define KSWZ(row, colB) ((row) * 256 + ((colB) ^ (((row) & 15) << 4)))
#define SBAR() __builtin_amdgcn_sched_barrier(0)
__device__ __forceinline__ int crow(int r, int hi) { return (r & 3) + 8 * (r >> 2) + 4 * hi; }

__device__ __forceinline__ void partialSM(f32x16& p0, f32x16& p1, float& m_reg, float& mn, float& alpha) {
  float pmax = p0[0];
#pragma unroll
  for (int r = 1; r < 16; ++r) pmax = fmaxf(pmax, p0[r]);
#pragma unroll
  for (int r = 0; r < 16; ++r) pmax = fmaxf(pmax, p1[r]);
  { auto rr = __builtin_amdgcn_permlane32_swap(__float_as_uint(pmax), __float_as_uint(pmax), false, false);
    pmax = fmaxf(__uint_as_float(rr[0]), __uint_as_float(rr[1])); }
  mn = 0.f;
  if (__builtin_expect(__all(pmax <= THR2), 1)) { alpha = 1.f; }
  else { const float sh = fmaxf(pmax, 0.f); alpha = __builtin_amdgcn_exp2f(-sh); m_reg += sh;
#pragma unroll
    for (int r = 0; r < 16; ++r) { p0[r] -= sh; p1[r] -= sh; } }
#pragma unroll
  for (int r = 0; r < 16; ++r) p0[r] = __builtin_amdgcn_exp2f(p0[r]);
}
__device__ __forceinline__ void finishSM(f32x16& p0, f32x16& p1, float alpha, float& l_reg, bf16x8& pa0, bf16x8& pa1, bf16x8& pa2, bf16x8& pa3) {
#pragma unroll
  for (int r = 0; r < 16; ++r) p1[r] = __builtin_amdgcn_exp2f(p1[r]);
  float ps = 0;
#pragma unroll
  for (int r = 0; r < 16; ++r) ps += p0[r];
#pragma unroll
  for (int r = 0; r < 16; ++r) ps += p1[r];
  { auto rr = __builtin_amdgcn_permlane32_swap(__float_as_uint(ps), __float_as_uint(ps), false, false);
    ps = __uint_as_float(rr[0]) + __uint_as_float(rr[1]); }
  l_reg = l_reg * alpha + ps;
#define PK4(P, BASE, OUT) do { unsigned a0 = cvt_pk_bf16(P[BASE + 0], P[BASE + 1]), a1 = cvt_pk_bf16(P[BASE + 2], P[BASE + 3]);   \
    unsigned b0 = cvt_pk_bf16(P[BASE + 4], P[BASE + 5]), b1 = cvt_pk_bf16(P[BASE + 6], P[BASE + 7]);                              \
    auto r0 = __builtin_amdgcn_permlane32_swap(a0, b0, false, false); auto r1 = __builtin_amdgcn_permlane32_swap(a1, b1, false, false); \
    u32x4 w = {r0[0], r1[0], r0[1], r1[1]}; OUT = *reinterpret_cast<bf16x8*>(&w); } while (0)
  PK4(p0, 0, pa0); PK4(p0, 8, pa1); PK4(p1, 0, pa2); PK4(p1, 8, pa3);
#undef PK4
}
__device__ __forceinline__ void qkt(f32x16& p0, f32x16& p1, const char* Ks, const bf16x8* qr, int r32, int hi, float mref = 0.f) {
  { const float i0 = -mref; p0 = (f32x16){i0, i0, i0, i0, i0, i0, i0, i0, i0, i0, i0, i0, i0, i0, i0, i0}; p1 = p0; }
#pragma unroll
  for (int d0 = 0; d0 < 6; ++d0) { const int cb = (d0 * 16 + hi * 8) * 2;
    bf16x8 b0 = *reinterpret_cast<const bf16x8*>(Ks + KSWZ(r32, cb));
    bf16x8 b1 = *reinterpret_cast<const bf16x8*>(Ks + KSWZ(32 + r32, cb));
    p0 = __builtin_amdgcn_mfma_f32_32x32x16_bf16(b0, qr[d0], p0, 0, 0, 0);
    p1 = __builtin_amdgcn_mfma_f32_32x32x16_bf16(b1, qr[d0], p1, 0, 0, 0); }
}
__device__ __forceinline__ int v_st(int k, int c) { const int kk = (k & ~0xC) | ((k & 4) << 1) | ((k & 8) >> 1); return ((kk >> 3) * 2 + (c >> 5)) * 512 + ((kk & 7) * 32 + (c & 31)) * 2; }
__device__ __forceinline__ int v_rd_base(int lane) { return ((lane & 3) << 3) | (((lane >> 2) & 3) << 6) | (((lane >> 4) & 1) << 5) | (((lane >> 5) & 1) << 8); }
constexpr int v_rd_off(int d0, int ks, int half) { return d0 * 512 + ks * 2048 + half * 1024; }
template <int OFF> __device__ __forceinline__ s16x4 tr_read(int vb) {
  s16x4 r; asm volatile("ds_read_b64_tr_b16 %0, %1 offset:%2" : "=&v"(r) : "v"(vb), "i"(OFF) : "memory"); return r;
}
template <int D0> __device__ __forceinline__ void pv_one(f32x16& od, int vb, bf16x8 pa0, bf16x8 pa1, bf16x8 pa2, bf16x8 pa3) {
  const s16x4 l0 = tr_read<v_rd_off(D0, 0, 0)>(vb), h0 = tr_read<v_rd_off(D0, 0, 1)>(vb), l1 = tr_read<v_rd_off(D0, 1, 0)>(vb), h1 = tr_read<v_rd_off(D0, 1, 1)>(vb);
  const s16x4 l2 = tr_read<v_rd_off(D0, 2, 0)>(vb), h2 = tr_read<v_rd_off(D0, 2, 1)>(vb), l3 = tr_read<v_rd_off(D0, 3, 0)>(vb), h3 = tr_read<v_rd_off(D0, 3, 1)>(vb);
  asm volatile("s_waitcnt lgkmcnt(0)" ::: "memory"); SBAR();
#define PK(L, H) (bf16x8){L[0], L[1], L[2], L[3], H[0], H[1], H[2], H[3]}
  od = __builtin_amdgcn_mfma_f32_32x32x16_bf16(pa0, PK(l0, h0), od, 0, 0, 0);
  od = __builtin_amdgcn_mfma_f32_32x32x16_bf16(pa1, PK(l1, h1), od, 0, 0, 0);
  od = __builtin_amdgcn_mfma_f32_32x32x16_bf16(pa2, PK(l2, h2), od, 0, 0, 0);
  od = __builtin_amdgcn_mfma_f32_32x32x16_bf16(pa3, PK(l3, h3), od, 0, 0, 0);
#undef PK
}
__device__ __forceinline__ void pv_d0(f32x16* o, int vb, bf16x8 pa0, bf16x8 pa1, bf16x8 pa2, bf16x8 pa3) {
  pv_one<0>(o[0], vb, pa0, pa1, pa2, pa3); pv_one<1>(o[1], vb, pa0, pa1, pa2, pa3);
}

template <int MODE = 0>
__device__ __forceinline__ void attn_body(const bf16_t* __restrict__ Qb, const bf16_t* __restrict__ Kh, const bf16_t* __restrict__ Vh, bf16_t* __restrict__ Ob, int ldo, int seq, char* lds, const int tid) {
  const int wid = tid >> 6, lane = tid & 63, r32 = lane & 31, hi = lane >> 5;
  char* V_lds = lds; char* K_lds = lds + 3 * SHM_V;
  float* ws = (float*)(lds + 3 * SHM_V + 2 * SHM_K) + wid * 64; float* li_l = ws; float* al_l = ws + 32;
  float m_reg = 0.f, l_reg = 0; f32x16 o[2] = {}; bf16x8 qr[6];
  const bf16_t* Qw = Qb + (long)(wid * QBLK + r32) * DQ + hi * 8;
#pragma unroll
  for (int d0 = 0; d0 < 6; ++d0) qr[d0] = *reinterpret_cast<const bf16x8*>(Qw + d0 * 16);
  const int id1 = (tid < 256) ? 512 + tid : tid;
  const int kr0 = tid / 12, kc0 = tid - kr0 * 12, kr1 = id1 / 12, kc1 = id1 - kr1 * 12;
  const int vr = tid >> 3, vc = (tid & 7) * 8;
  const int kst0 = KSWZ(kr0, kc0 * 16), kst1 = KSWZ(kr1, kc1 * 16), vst = v_st(vr, vc);
  const int vb0 = (int)(uintptr_t)V_lds + v_rd_base(lane);
  struct { bf16x8 vs, ks0, ks1; } sr_[2];
  const unsigned koff0 = (unsigned)(kr0 * DQ + kc0 * 8) * 2u, koff1 = (unsigned)(kr1 * DQ + kc1 * 8) * 2u, voff0 = (unsigned)(vr * DV + vc) * 2u;
#define SLOAD(i, k0) do { const char* kt_ = (const char*)Kh + (size_t)(k0) * (DQ * 2); const char* vt_ = (const char*)Vh + (size_t)(k0) * (DV * 2); \
    sr_[i].vs = *reinterpret_cast<const bf16x8*>(vt_ + voff0); sr_[i].ks0 = *reinterpret_cast<const bf16x8*>(kt_ + koff0); sr_[i].ks1 = *reinterpret_cast<const bf16x8*>(kt_ + koff1); } while (0)
#define SWRITE(b, vsl, i) do { *(bf16x8*)(V_lds + (vsl) * SHM_V + vst) = sr_[i].vs; *(bf16x8*)(K_lds + (b) * SHM_K + kst0) = sr_[i].ks0;          \
    if (tid < 256) *(bf16x8*)(K_lds + (b) * SHM_K + kst1) = sr_[i].ks1; } while (0)
#define SWAIT() asm volatile("s_waitcnt vmcnt(3)" ::: "memory")
#define RESC(a) do { if (__any((a) < 1.f)) { if (hi == 0) al_l[r32] = (a); asm volatile("s_waitcnt lgkmcnt(0)" ::: "memory"); \
    _Pragma("unroll") for (int d = 0; d < 2; ++d) _Pragma("unroll") for (int r = 0; r < 16; ++r) o[d][r] *= al_l[crow(r, hi)]; } } while (0)
  f32x16 pA0, pA1, pB0, pB1; float mnA, mnB, alA, alB; bf16x8 pa0, pa1, pa2, pa3; const int NT = seq / KVBLK;
  constexpr int SE = 0, SO = 1;
  SLOAD(SE, 0); asm volatile("s_waitcnt vmcnt(0)" ::: "memory"); SWRITE(0, 0, SE); __syncthreads();
  if (MODE != 2) qkt(pA0, pA1, K_lds, qr, r32, hi, m_reg); else { pA0 = f32x16{}; pA1 = f32x16{}; } if (MODE != 1) partialSM(pA0, pA1, m_reg, mnA, alA); else { mnA = 0; alA = 1; }
  SLOAD(SO, KVBLK); if (2 < NT) SLOAD(SE, 2 * KVBLK);
  SWAIT(); SWRITE(1, 1, SO); __syncthreads();
  int vsl = 0;
  for (int j = 1; j + 1 < NT; j += 2) {
    SBAR(); if (MODE != 2) qkt(pB0, pB1, K_lds + SHM_K, qr, r32, hi, m_reg); else { pB0 = f32x16{}; pB1 = f32x16{}; }
    if (MODE != 1) finishSM(pA0, pA1, alA, l_reg, pa0, pa1, pa2, pa3); else { pa0 = qr[0]; pa1 = qr[1]; pa2 = qr[2]; pa3 = qr[3]; } SBAR();
    if (MODE != 3) SLOAD(SO, (j + 2) * KVBLK); SBAR();
    if (MODE != 2) pv_d0(o, vb0 + vsl * (int)SHM_V, pa0, pa1, pa2, pa3); if (MODE != 1) partialSM(pB0, pB1, m_reg, mnB, alB); else { mnB = 0; alB = 1; }
    { int vw = vsl + 2; if (vw >= 3) vw -= 3; if (MODE != 3) { SWAIT(); SWRITE(0, vw, SE); } }
    RESC(alB); __syncthreads();
    vsl = (vsl == 2) ? 0 : vsl + 1;
    SBAR(); if (MODE != 2) qkt(pA0, pA1, K_lds, qr, r32, hi, m_reg); else { pA0 = f32x16{}; pA1 = f32x16{}; }
    if (MODE != 1) finishSM(pB0, pB1, alB, l_reg, pa0, pa1, pa2, pa3); else { pa0 = qr[0]; pa1 = qr[1]; pa2 = qr[2]; pa3 = qr[3]; } SBAR();
    if (MODE != 3) { if (j + 3 < NT) SLOAD(SE, (j + 3) * KVBLK); } SBAR();
    if (MODE != 2) pv_d0(o, vb0 + vsl * (int)SHM_V, pa0, pa1, pa2, pa3); if (MODE != 1) partialSM(pA0, pA1, m_reg, mnA, alA); else { mnA = 0; alA = 1; }
    { int vw = vsl + 2; if (vw >= 3) vw -= 3; if (MODE != 3) { SWAIT(); SWRITE(1, vw, SO); } }
    RESC(alA); __syncthreads();
    vsl = (vsl == 2) ? 0 : vsl + 1;
  }
  SBAR(); qkt(pB0, pB1, K_lds + SHM_K, qr, r32, hi, m_reg);
  finishSM(pA0, pA1, alA, l_reg, pa0, pa1, pa2, pa3); SBAR();
  pv_d0(o, vb0 + vsl * (int)SHM_V, pa0, pa1, pa2, pa3); partialSM(pB0, pB1, m_reg, mnB, alB);
  RESC(alB);
  vsl = (vsl == 2) ? 0 : vsl + 1;
  finishSM(pB0, pB1, alB, l_reg, pa0, pa1, pa2, pa3); SBAR();
  pv_d0(o, vb0 + vsl * (int)SHM_V, pa0, pa1, pa2, pa3);
  if (hi == 0) li_l[r32] = l_reg; asm volatile("s_waitcnt lgkmcnt(0)" ::: "memory");
  float rli[16];
#pragma unroll
  for (int r = 0; r < 16; ++r) rli[r] = __builtin_amdgcn_rcpf(li_l[crow(r, hi)]);
  bf16_t* Ow = Ob + (long)(wid * QBLK) * ldo;
#pragma unroll
  for (int r = 0; r < 16; ++r) { const int orow = crow(r, hi);
#pragma unroll
    for (int d0 = 0; d0 < 2; ++d0) Ow[(long)orow * ldo + d0 * 32 + r32] = f2bf(o[d0][r] * rli[r]); }
  __syncthreads();
#undef SLOAD
#undef SWRITE
#undef SWAIT
#undef RESC
}

constexpr int SHM_ATTN2 = 3 * SHM_V + 3 * SHM_K + NW * 64 * 4;
__device__ __forceinline__ void softmax_tile(f32x16& p0, f32x16& p1, float& m_reg, float& l_reg, float& alpha, bf16x8& pa0, bf16x8& pa1, bf16x8& pa2, bf16x8& pa3) {
  float mx[4], sm[4];
#pragma unroll
  for (int g = 0; g < 2; ++g) { mx[g] = fmaxf(fmaxf(fmaxf(p0[8 * g], p0[8 * g + 1]), fmaxf(p0[8 * g + 2], p0[8 * g + 3])), fmaxf(fmaxf(p0[8 * g + 4], p0[8 * g + 5]), fmaxf(p0[8 * g + 6], p0[8 * g + 7])));
      mx[2 + g] = fmaxf(fmaxf(fmaxf(p1[8 * g], p1[8 * g + 1]), fmaxf(p1[8 * g + 2], p1[8 * g + 3])), fmaxf(fmaxf(p1[8 * g + 4], p1[8 * g + 5]), fmaxf(p1[8 * g + 6], p1[8 * g + 7]))); }
  float pmax = fmaxf(fmaxf(mx[0], mx[1]), fmaxf(mx[2], mx[3]));
  { auto rr = __builtin_amdgcn_permlane32_swap(__float_as_uint(pmax), __float_as_uint(pmax), false, false);
    pmax = fmaxf(__uint_as_float(rr[0]), __uint_as_float(rr[1])); }
  float mn;
  if (__builtin_expect(__all(pmax - m_reg <= THR2), 1)) { mn = m_reg; alpha = 1.f; }
  else { mn = fmaxf(m_reg, pmax); alpha = __builtin_amdgcn_exp2f(m_reg - mn); m_reg = mn; }
#pragma unroll
  for (int r = 0; r < 16; ++r) { p0[r] = __builtin_amdgcn_exp2f(p0[r] - mn); p1[r] = __builtin_amdgcn_exp2f(p1[r] - mn); }
#pragma unroll
  for (int g = 0; g < 2; ++g) { sm[g] = ((p0[8 * g] + p0[8 * g + 1]) + (p0[8 * g + 2] + p0[8 * g + 3])) + ((p0[8 * g + 4] + p0[8 * g + 5]) + (p0[8 * g + 6] + p0[8 * g + 7]));
      sm[2 + g] = ((p1[8 * g] + p1[8 * g + 1]) + (p1[8 * g + 2] + p1[8 * g + 3])) + ((p1[8 * g + 4] + p1[8 * g + 5]) + (p1[8 * g + 6] + p1[8 * g + 7])); }
  float ps = (sm[0] + sm[1]) + (sm[2] + sm[3]);
  { auto rr = __builtin_amdgcn_permlane32_swap(__float_as_uint(ps), __float_as_uint(ps), false, false);
    ps = __uint_as_float(rr[0]) + __uint_as_float(rr[1]); }
  l_reg = l_reg * alpha + ps;
#define PK4(P, BASE, OUT) do { unsigned a0 = cvt_pk_bf16(P[BASE + 0], P[BASE + 1]), a1 = cvt_pk_bf16(P[BASE + 2], P[BASE + 3]);   \
    unsigned b0 = cvt_pk_bf16(P[BASE + 4], P[BASE + 5]), b1 = cvt_pk_bf16(P[BASE + 6], P[BASE + 7]);                              \
    auto r0 = __builtin_amdgcn_permlane32_swap(a0, b0, false, false); auto r1 = __builtin_amdgcn_permlane32_swap(a1, b1, false, false); \
    u32x4 w = {r0[0], r1[0], r0[1], r1[1]}; OUT = *reinterpret_cast<bf16x8*>(&w); } while (0)
  PK4(p0, 0, pa0); PK4(p0, 8, pa1); PK4(p1, 0, pa2); PK4(p1, 8, pa3);
#undef PK4
}
template <int MODE = 0>
__device__ __forceinline__ void attn_body2(const bf16_t* __restrict__ Qb, const bf16_t* __restrict__ Kh, const bf16_t* __restrict__ Vh, bf16_t* __restrict__ Ob, int ldo, int seq, char* lds, const int tid) {
  const int wid = tid >> 6, lane = tid & 63, r32 = lane & 31, hi = lane >> 5; const bool late = wid >= 4;
  char* V_lds = lds; char* K_lds = lds + 3 * SHM_V;
  float* ws = (float*)(lds + 3 * SHM_V + 3 * SHM_K) + wid * 64; float* li_l = ws; float* al_l = ws + 32;
  float m_reg = -1e30f, l_reg = 0, alpha = 1.f; f32x16 o[2] = {}; bf16x8 qr[6];
  const bf16_t* Qw = Qb + (long)(wid * QBLK + r32) * DQ + hi * 8;
#pragma unroll
  for (int d0 = 0; d0 < 6; ++d0) qr[d0] = *reinterpret_cast<const bf16x8*>(Qw + d0 * 16);
  const int id1 = (tid < 256) ? 512 + tid : tid;
  const int kr0 = tid / 12, kc0 = tid - kr0 * 12, kr1 = id1 / 12, kc1 = id1 - kr1 * 12;
  const int vr = tid >> 3, vc = (tid & 7) * 8;
  const int kst0 = KSWZ(kr0, kc0 * 16), kst1 = KSWZ(kr1, kc1 * 16), vst = v_st(vr, vc);
  const int vbase = (int)(uintptr_t)V_lds + v_rd_base(lane);
  struct { bf16x8 vs, ks0, ks1; } sr_[2];
  const unsigned koff0 = (unsigned)(kr0 * DQ + kc0 * 8) * 2u, koff1 = (unsigned)(kr1 * DQ + kc1 * 8) * 2u, voff0 = (unsigned)(vr * DV + vc) * 2u;
#define LOADK(i, t) do { const char* kt_ = (const char*)Kh + (size_t)(t) * (KVBLK * DQ * 2); sr_[i].ks0 = *reinterpret_cast<const bf16x8*>(kt_ + koff0); sr_[i].ks1 = *reinterpret_cast<const bf16x8*>(kt_ + koff1); } while (0)
#define LOADV(i, t) do { const char* vt_ = (const char*)Vh + (size_t)(t) * (KVBLK * DV * 2); sr_[i].vs = *reinterpret_cast<const bf16x8*>(vt_ + voff0); } while (0)
#define WRITEK(i, slot) do { *(bf16x8*)(K_lds + (slot) * SHM_K + kst0) = sr_[i].ks0; if (tid < 256) *(bf16x8*)(K_lds + (slot) * SHM_K + kst1) = sr_[i].ks1; } while (0)
#define WRITEV(i, slot) do { *(bf16x8*)(V_lds + (slot) * SHM_V + vst) = sr_[i].vs; } while (0)
#define RESC(a) do { if (__any((a) < 1.f)) { if (hi == 0) al_l[r32] = (a); asm volatile("s_waitcnt lgkmcnt(0)" ::: "memory"); \
    _Pragma("unroll") for (int d = 0; d < 2; ++d) _Pragma("unroll") for (int r = 0; r < 16; ++r) o[d][r] *= al_l[crow(r, hi)]; } } while (0)
  f32x16 p0, p1; bf16x8 pa0, pa1, pa2, pa3; const int NT = seq / KVBLK;
  bf16x8 kf[3][2];
  LOADK(0, 0); LOADV(0, 0); LOADK(1, 1);
  asm volatile("s_waitcnt vmcnt(0)" ::: "memory");
  WRITEK(0, 0); WRITEV(0, 0); WRITEK(1, 1);
  LOADK(0, 2); LOADV(0, 1); LOADK(1, 3); LOADV(1, 2);
  __syncthreads();
#define RDK(slot) do { const char* Ks_ = K_lds + (slot) * SHM_K; _Pragma("unroll") for (int d0 = 0; d0 < 3; ++d0) { const int cb = (d0 * 16 + hi * 8) * 2; \
      kf[d0][0] = *reinterpret_cast<const bf16x8*>(Ks_ + KSWZ(r32, cb)); kf[d0][1] = *reinterpret_cast<const bf16x8*>(Ks_ + KSWZ(32 + r32, cb)); } } while (0)
#define RDKH(dst, slot) do { const char* Ks_ = K_lds + (slot) * SHM_K; _Pragma("unroll") for (int d0 = 3; d0 < 6; ++d0) { const int cb = (d0 * 16 + hi * 8) * 2; \
      dst[d0 - 3][0] = *reinterpret_cast<const bf16x8*>(Ks_ + KSWZ(r32, cb)); dst[d0 - 3][1] = *reinterpret_cast<const bf16x8*>(Ks_ + KSWZ(32 + r32, cb)); } } while (0)
#define RDV(dst, D, slot) do { const int vb_ = vbase + (slot) * (int)SHM_V; \
      dst[0][0] = tr_read<v_rd_off(D, 0, 0)>(vb_); dst[0][1] = tr_read<v_rd_off(D, 0, 1)>(vb_); dst[1][0] = tr_read<v_rd_off(D, 1, 0)>(vb_); dst[1][1] = tr_read<v_rd_off(D, 1, 1)>(vb_); \
      dst[2][0] = tr_read<v_rd_off(D, 2, 0)>(vb_); dst[2][1] = tr_read<v_rd_off(D, 2, 1)>(vb_); dst[3][0] = tr_read<v_rd_off(D, 3, 0)>(vb_); dst[3][1] = tr_read<v_rd_off(D, 3, 1)>(vb_); } while (0)
#define VPK(v, k) (bf16x8){v[k][0][0], v[k][0][1], v[k][0][2], v[k][0][3], v[k][1][0], v[k][1][1], v[k][1][2], v[k][1][3]}
#define PV4(od, v) do { if (MODE == 2) { od[0] += (float)v[0][0][0] + (float)v[1][1][0] + (float)v[2][0][1] + (float)v[3][1][2]; break; } od = __builtin_amdgcn_mfma_f32_32x32x16_bf16(pa0, VPK(v, 0), od, 0, 0, 0); od = __builtin_amdgcn_mfma_f32_32x32x16_bf16(pa1, VPK(v, 1), od, 0, 0, 0); \
      od = __builtin_amdgcn_mfma_f32_32x32x16_bf16(pa2, VPK(v, 2), od, 0, 0, 0); od = __builtin_amdgcn_mfma_f32_32x32x16_bf16(pa3, VPK(v, 3), od, 0, 0, 0); } while (0)
#define QK2(kk, d0) do { if (MODE != 2) { p0 = __builtin_amdgcn_mfma_f32_32x32x16_bf16(kk[0], qr[d0], p0, 0, 0, 0); p1 = __builtin_amdgcn_mfma_f32_32x32x16_bf16(kk[1], qr[d0], p1, 0, 0, 0); } else { p0[d0] += __builtin_bit_cast(float, (int)kk[0][0]); p1[d0] += __builtin_bit_cast(float, (int)kk[1][1]); } } while (0)
#define LGKM0() do { asm volatile("s_waitcnt lgkmcnt(0)" ::: "memory"); SBAR(); } while (0)
  RDK(0);
  if (late) __syncthreads();
  int ks = 0, vs = 0;
#define SEG_X(j) do { bf16x8 kfh[3][2]; s16x4 va[4][2], vb2[4][2]; LGKM0(); \
    p0 = f32x16{}; p1 = f32x16{}; \
    QK2(kf[0], 0); SBAR(); RDKH(kfh, ks); SBAR(); QK2(kf[1], 1); QK2(kf[2], 2); \
    LGKM0(); if ((j) > 0) { RDV(va, 0, vs); SBAR(); } \
    QK2(kfh[0], 3); QK2(kfh[1], 4); QK2(kfh[2], 5); \
    if ((j) > 0) { LGKM0(); RDV(vb2, 1, vs); SBAR(); PV4(o[0], va); LGKM0(); PV4(o[1], vb2); } \
    SBAR(); } while (0)
#define SEG_Y(j, i) do { asm volatile("s_waitcnt vmcnt(3)" ::: "memory"); \
    { int k2 = ks + 2; if (k2 >= 3) k2 -= 3; int k1 = ks + 1; if (k1 >= 3) k1 -= 3; \
      if ((j) + 2 < NT) WRITEK(i, k2); if ((j) + 1 < NT) WRITEV(i, k1); \
      if ((j) + 4 < NT) LOADK(i, (j) + 4); if ((j) + 3 < NT) LOADV(i, (j) + 3); \
      if ((j) + 1 < NT) RDK(k1); vs = ks; ks = k1; } \
    if (MODE != 1) { softmax_tile(p0, p1, m_reg, l_reg, alpha, pa0, pa1, pa2, pa3); RESC(alpha); } else { pa0 = qr[0]; pa1 = qr[1]; pa2 = qr[2]; pa3 = qr[3]; } } while (0)
  for (int j = 0; j < NT; j += 2) {
    SEG_X(j); __syncthreads();
    SEG_Y(j, 0); __syncthreads();
    SEG_X(j + 1); __syncthreads();
    SEG_Y(j + 1, 1); __syncthreads();
  }
  { s16x4 va[4][2], vb2[4][2]; RDV(va, 0, vs); RDV(vb2, 1, vs); LGKM0(); PV4(o[0], va); PV4(o[1], vb2); }
  if (!late) __syncthreads();
  if (hi == 0) li_l[r32] = l_reg; asm volatile("s_waitcnt lgkmcnt(0)" ::: "memory");
  float rli[16];
#pragma unroll
  for (int r = 0; r < 16; ++r) rli[r] = __builtin_amdgcn_rcpf(li_l[crow(r, hi)]);
  bf16_t* Ow = Ob + (long)(wid * QBLK) * ldo;
#pragma unroll
  for (int r = 0; r < 16; ++r) { const int orow = crow(r, hi);
#pragma unroll
    for (int d0 = 0; d0 < 2; ++d0) Ow[(long)orow * ldo + d0 * 32 + r32] = f2bf(o[d0][r] * rli[r]); }
  __syncthreads();
#undef LOADK
#undef LOADV
#undef WRITEK
#undef WRITEV
#undef RESC
#undef SEG_X
#undef SEG_Y
#undef RDK
#undef RDKH
#undef RDV
#undef VPK
#undef PV4
#undef QK2
#undef LGKM0
}
}
namespace rw {
constexpr int CS = 32;
__device__ __forceinline__ int lane_id() { return (int)__builtin_amdgcn_mbcnt_hi(~0u, __builtin_amdgcn_mbcnt_lo(~0u, 0u)); }
struct Ptrs { const bf16_t *LW, *AA, *RWR, *RWK, *RWV, *RWKK; const float* ka; u32x4 *RG, *RH, *RRH, *RY0, *ZS; float* YR; float* YRB; bf16_t* GGRP; u32x4 *HGRP, *ZGRP; };
__device__ __forceinline__ f32x16 mma(bf16x8 a, bf16x8 b, f32x16 c) { return __builtin_amdgcn_mfma_f32_32x32x16_bf16(a, b, c, 0, 0, 0); }
__device__ __forceinline__ bf16x8 pk8(const f32x16& t, int s2) {
    u32x4 w; if (s2 == 0) { w.x = cvt_pk_bf16(t[0], t[1]); w.y = cvt_pk_bf16(t[2], t[3]); w.z = cvt_pk_bf16(t[4], t[5]); w.w = cvt_pk_bf16(t[6], t[7]); }
    else { w.x = cvt_pk_bf16(t[8], t[9]); w.y = cvt_pk_bf16(t[10], t[11]); w.z = cvt_pk_bf16(t[12], t[13]); w.w = cvt_pk_bf16(t[14], t[15]); }
    return *(bf16x8*)&w; }
struct Pk2 { bf16x8 f[2]; };
__device__ __forceinline__ Pk2 pk16(const f32x16& t) { Pk2 p; p.f[0] = pk8(t, 0); p.f[1] = pk8(t, 1); return p; }
__device__ __forceinline__ f32x16 type2(const Pk2& x, const Pk2& y, f32x16 acc) { acc = mma(x.f[0], y.f[0], acc); acc = mma(x.f[1], y.f[1], acc); return acc; }
__device__ __forceinline__ f32x16 unpk16(u32x4 lo, u32x4 hi) { f32x16 t; t[0] = bflo(lo.x); t[1] = bfhi(lo.x); t[2] = bflo(lo.y); t[3] = bfhi(lo.y); t[4] = bflo(lo.z); t[5] = bfhi(lo.z); t[6] = bflo(lo.w); t[7] = bfhi(lo.w);
    t[8] = bflo(hi.x); t[9] = bfhi(hi.x); t[10] = bflo(hi.y); t[11] = bfhi(hi.y); t[12] = bflo(hi.z); t[13] = bfhi(hi.z); t[14] = bflo(hi.w); t[15] = bfhi(hi.w); return t; }

__device__ __forceinline__ void r1_item(const Ptrs& P, int item, LAS float* lds) {
    const int chain = item / NCH, c = item - chain * NCH; const int h = chain & 7, dir = (chain >> 3) & 1, b = chain >> 4;
    int lane = lane_id(); asm volatile("" : "+v"(lane)); const int r32 = lane & 31, hi = lane >> 5;
    const int rowbase = dir == 0 ? 32 * c : (c < 8 ? 255 - 32 * c : 16895 - 32 * c), rstep = dir ? -1 : 1;
    const bf16_t* LWp = P.LW + (size_t)chain * SB * 64; const bf16_t* AAp = P.AA + (size_t)chain * SB * 64;
    const size_t headoff = (size_t)(b * 8 + h) * SB * 64;
    LAS float* cumL = lds;
    { float lwv[32];
#pragma unroll
      for (int n = 0; n < 32; ++n) lwv[n] = bf2f(LWp[(size_t)(rowbase + rstep * n) * 64 + lane]);
      float run = 0.f;
#pragma unroll
      for (int n = 0; n < 32; ++n) { run += lwv[n]; cumL[n * 68 + lane] = run; } }
    bf16x8 Af[4], Bf[4], Kf[4], Rf[4], Vf[4];
    { const size_t row = (size_t)(rowbase + rstep * r32) * 64;
#pragma unroll
      for (int ks = 0; ks < 4; ++ks) { const int ch0 = 16 * ks + 8 * hi; const size_t o1 = row + ch0;
        float lw[8], aa[8], k_[8], kk_[8], r_[8], cm[8];
        unpack8(*(const u32x4*)(LWp + o1), lw); unpack8(*(const u32x4*)(AAp + o1), aa); unpack8(*(const u32x4*)(P.RWK + headoff + o1), k_); unpack8(*(const u32x4*)(P.RWKK + headoff + o1), kk_);
        unpack8(*(const u32x4*)(P.RWR + headoff + o1), r_); Vf[ks] = *(const bf16x8*)(P.RWV + headoff + o1);
        { const f32x4 c0 = *(const LAS f32x4*)(cumL + r32 * 68 + ch0), c1 = *(const LAS f32x4*)(cumL + r32 * 68 + ch0 + 4); cm[0] = c0[0]; cm[1] = c0[1]; cm[2] = c0[2]; cm[3] = c0[3]; cm[4] = c1[0]; cm[5] = c1[1]; cm[6] = c1[2]; cm[7] = c1[3]; }
        const f32x4 ka0 = *(const f32x4*)(P.ka + h * 64 + ch0), ka1 = *(const f32x4*)(P.ka + h * 64 + ch0 + 4);
        float at[8], bt[8], kt[8], rt[8];
#pragma unroll
        for (int q = 0; q < 8; ++q) { const float ep = __expf(cm[q]), em = __expf(-cm[q]), ex = __expf(cm[q] - lw[q]); const float kav = q < 4 ? ka0[q & 3] : ka1[q & 3];
            at[q] = -kk_[q] * ex; bt[q] = kk_[q] * aa[q] * em; kt[q] = k_[q] * (1.f + (aa[q] - 1.f) * kav) * em; rt[q] = r_[q] * ep; }
        { u32x4 w = pack8(at); Af[ks] = *(bf16x8*)&w; w = pack8(bt); Bf[ks] = *(bf16x8*)&w; w = pack8(kt); Kf[ks] = *(bf16x8*)&w; w = pack8(rt); Rf[ks] = *(bf16x8*)&w; }
      } }
    const float g0 = __expf(cumL[31 * 68 + r32]), g1 = __expf(cumL[31 * 68 + 32 + r32]);
    const f32x16 zero16 = {0.f, 0.f, 0.f, 0.f, 0.f, 0.f, 0.f, 0.f, 0.f, 0.f, 0.f, 0.f, 0.f, 0.f, 0.f, 0.f};
    Pk2 LTak, MTrb, MTrk;
    Pk2 Mk, Pk;
    { f32x16 t = zero16;
#pragma unroll
      for (int ks = 0; ks < 4; ++ks) t = mma(Bf[ks], Af[ks], t);
#pragma unroll
      for (int r = 0; r < 16; ++r) { const int s_ = (r & 3) + 8 * (r >> 2) + 4 * hi; t[r] = (s_ < r32) ? t[r] : 0.f; }
      Mk = pk16(t); t = zero16;
#pragma unroll
      for (int ks = 0; ks < 4; ++ks) t = mma(Af[ks], Bf[ks], t);
#pragma unroll
      for (int r = 0; r < 16; ++r) { const int t_ = (r & 3) + 8 * (r >> 2) + 4 * hi; t[r] = (r32 < t_) ? t[r] : 0.f; }
      Pk = pk16(t);
      t = zero16;
#pragma unroll
      for (int ks = 0; ks < 4; ++ks) t = mma(Kf[ks], Af[ks], t);
#pragma unroll
      for (int r = 0; r < 16; ++r) { const int s = (r & 3) + 8 * (r >> 2) + 4 * hi; t[r] = (s < r32) ? t[r] : 0.f; }
      LTak = pk16(t);
      t = zero16;
#pragma unroll
      for (int ks = 0; ks < 4; ++ks) t = mma(Bf[ks], Rf[ks], t);
#pragma unroll
      for (int r = 0; r < 16; ++r) { const int s = (r & 3) + 8 * (r >> 2) + 4 * hi; t[r] = (s <= r32) ? t[r] : 0.f; }
      MTrb = pk16(t);
      t = zero16;
#pragma unroll
      for (int ks = 0; ks < 4; ++ks) t = mma(Kf[ks], Rf[ks], t);
#pragma unroll
      for (int r = 0; r < 16; ++r) { const int s = (r & 3) + 8 * (r >> 2) + 4 * hi; t[r] = (s <= r32) ? t[r] : 0.f; }
      MTrk = pk16(t); }
    bf16x8 If[2];
#pragma unroll
    for (int e = 0; e < 2; ++e) { const int jj0 = r32 - 16 * e - 8 * hi; u32x4 w;
        w.x = (jj0 == 0 ? 0x3F80u : 0u) | (jj0 == 1 ? 0x3F800000u : 0u); w.y = (jj0 == 2 ? 0x3F80u : 0u) | (jj0 == 3 ? 0x3F800000u : 0u);
        w.z = (jj0 == 4 ? 0x3F80u : 0u) | (jj0 == 5 ? 0x3F800000u : 0u); w.w = (jj0 == 6 ? 0x3F80u : 0u) | (jj0 == 7 ? 0x3F800000u : 0u); If[e] = *(bf16x8*)&w; }
    f32x16 X[4];
    Pk2 Bh[2], Kh[2], Vc[2]; f32x16 RT[2];
#pragma unroll
    for (int tc = 0; tc < 2; ++tc) { const float g = tc ? g1 : g0;
        X[tc] = mma(Af[2 * tc + 1], If[1], mma(Af[2 * tc], If[0], zero16));
        f32x16 t = mma(Bf[2 * tc + 1], If[1], mma(Bf[2 * tc], If[0], zero16));
#pragma unroll
        for (int r = 0; r < 16; ++r) t[r] *= g;
        Bh[tc] = pk16(t);
        t = mma(Kf[2 * tc + 1], If[1], mma(Kf[2 * tc], If[0], zero16));
#pragma unroll
        for (int r = 0; r < 16; ++r) t[r] *= g;
        Kh[tc] = pk16(t);
        Vc[tc] = pk16(mma(Vf[2 * tc + 1], If[1], mma(Vf[2 * tc], If[0], zero16)));
        RT[tc] = mma(If[1], Rf[2 * tc + 1], mma(If[0], Rf[2 * tc], zero16));
    }
    X[2] = type2(LTak, Vc[0], zero16); X[3] = type2(LTak, Vc[1], zero16);
#pragma unroll
    for (int k = 0; k < 5; ++k) {
#pragma unroll
        for (int tl = 0; tl < 4; ++tl) X[tl] = type2(Mk, pk16(X[tl]), X[tl]);
        if (k < 4) { const Pk2 pn = pk16(type2(Mk, Pk, zero16)), mnx = pk16(type2(Pk, Mk, zero16)); Pk = pn; Mk = mnx; } }
    Pk2 Wc[2], Uc[2]; Wc[0] = pk16(X[0]); Wc[1] = pk16(X[1]); Uc[0] = pk16(X[2]); Uc[1] = pk16(X[3]);
#pragma unroll
    for (int jp = 0; jp < 2; ++jp)
#pragma unroll
        for (int jt = 0; jt < 2; ++jt) { f32x16 t = type2(Wc[jt], Bh[jp], zero16);
            if (jt == jp) { const float g = jp ? g1 : g0;
#pragma unroll
                for (int r = 0; r < 16; ++r) t[r] += (((r & 3) + 8 * (r >> 2) + 4 * hi) == r32) ? g : 0.f; }
            const Pk2 p = pk16(t);
            P.RG[((size_t)item * 8 + (jp * 2 + jt) * 2 + 0) * 64 + lane] = *(const u32x4*)&p.f[0]; P.RG[((size_t)item * 8 + (jp * 2 + jt) * 2 + 1) * 64 + lane] = *(const u32x4*)&p.f[1]; }
#pragma unroll
    for (int tj = 0; tj < 2; ++tj)
#pragma unroll
        for (int ti = 0; ti < 2; ++ti) { const f32x16 t = type2(Kh[tj], Vc[ti], type2(Bh[tj], Uc[ti], zero16));
            const Pk2 p = pk16(t);
            P.RH[(((size_t)item * 4 + tj * 2 + ti) * 64 + lane) * 2] = *(const u32x4*)&p.f[0]; P.RH[(((size_t)item * 4 + tj * 2 + ti) * 64 + lane) * 2 + 1] = *(const u32x4*)&p.f[1]; }
    if (c >= 8) {
        const int lanep = hi * 32 + (dir ? 31 - r32 : r32);
#pragma unroll
        for (int tj = 0; tj < 2; ++tj) { const f32x16 t = type2(Wc[tj], MTrb, RT[tj]);
            const Pk2 p = pk16(t);
            P.RRH[(((size_t)item * 2 + tj) * 2 + 0) * 64 + lanep] = *(const u32x4*)&p.f[0]; P.RRH[(((size_t)item * 2 + tj) * 2 + 1) * 64 + lanep] = *(const u32x4*)&p.f[1]; }
        const int lanepp = dir ? (lane ^ 32) : lane;
#pragma unroll
        for (int ti = 0; ti < 2; ++ti) { const f32x16 t = type2(MTrk, Vc[ti], type2(MTrb, Uc[ti], zero16));
            f32x16 o;
#pragma unroll
            for (int p = 0; p < 16; ++p) o[p] = dir ? t[(3 - (p & 3)) + 4 * (3 - (p >> 2))] : t[p];
            const Pk2 pq = pk16(o);
            P.RY0[(((size_t)item * 2 + ti) * 64 + lanepp) * 2] = *(const u32x4*)&pq.f[0]; P.RY0[(((size_t)item * 2 + ti) * 64 + lanepp) * 2 + 1] = *(const u32x4*)&pq.f[1]; }
    }
}

struct R2Set { u32x4 A[2][2][2]; u32x4 H[2][2]; };
__device__ __forceinline__ void r2_load(R2Set& S, const u32x4* RG, const u32x4* RH, size_t item, int it, int lane) {
#pragma unroll
    for (int jp = 0; jp < 2; ++jp) {
#pragma unroll
        for (int jt = 0; jt < 2; ++jt)
#pragma unroll
            for (int s = 0; s < 2; ++s) S.A[jp][jt][s] = RG[(item * 8 + (jp * 2 + jt) * 2 + s) * 64 + lane];
        S.H[jp][0] = RH[((item * 4 + jp * 2 + it) * 64 + lane) * 2]; S.H[jp][1] = RH[((item * 4 + jp * 2 + it) * 64 + lane) * 2 + 1]; }
}
__device__ __forceinline__ void r2_step(const R2Set& S, f32x16 (&Z)[2], u32x4* ZS, size_t item, int it, int lane) {
    Pk2 z[2]; z[0] = pk16(Z[0]); z[1] = pk16(Z[1]);
#pragma unroll
    for (int jt = 0; jt < 2; ++jt)
#pragma unroll
        for (int s = 0; s < 2; ++s) ZS[(((item * 2 + jt) * 2 + it) * 2 + s) * 64 + lane] = *(const u32x4*)&z[jt].f[s];
#pragma unroll
    for (int jp = 0; jp < 2; ++jp) { f32x16 acc = unpk16(S.H[jp][0], S.H[jp][1]);
#pragma unroll
        for (int jt = 0; jt < 2; ++jt)
#pragma unroll
            for (int s = 0; s < 2; ++s) acc = mma(*(const bf16x8*)&S.A[jp][jt][s], z[jt].f[s], acc);
        Z[jp] = acc; }
}
constexpr int GRP = 20, NGRP = NCH / GRP;
__device__ __forceinline__ void r2a_task(const Ptrs& P, int task, int lane) {
    const int ct = task & 3, cg = task >> 2; const int chain = cg / NGRP, g = cg - chain * NGRP, r32 = lane & 31, hi = lane >> 5; const int it = ct >= 2 ? ct - 2 : 0;
    const size_t base = (size_t)chain * NCH + (size_t)g * GRP;
    f32x16 Z[2];
#pragma unroll
    for (int jt = 0; jt < 2; ++jt)
#pragma unroll
        for (int r = 0; r < 16; ++r) Z[jt][r] = (ct < 2 && (32 * jt + (r & 3) + 8 * (r >> 2) + 4 * hi) == 32 * ct + r32) ? 1.f : 0.f;
    R2Set S0, S1;
    r2_load(S0, P.RG, P.RH, base, it, lane);
#pragma unroll 1
    for (int c = 0; c < GRP; c += 2) {
        r2_load(S1, P.RG, P.RH, base + c + 1, it, lane);
#pragma unroll
        for (int half = 0; half < 2; ++half) { const R2Set& S = half ? S1 : S0;
            Pk2 z[2]; z[0] = pk16(Z[0]); z[1] = pk16(Z[1]);
#pragma unroll
            for (int jp = 0; jp < 2; ++jp) { f32x16 acc = unpk16(S.H[jp][0], S.H[jp][1]);
                if (ct < 2) {
#pragma unroll
                    for (int r = 0; r < 16; ++r) acc[r] = 0.f; }
#pragma unroll
                for (int jt = 0; jt < 2; ++jt)
#pragma unroll
                    for (int s2 = 0; s2 < 2; ++s2) acc = mma(*(const bf16x8*)&S.A[jp][jt][s2], z[jt].f[s2], acc);
                Z[jp] = acc; }
            if (half == 0 && c + 2 < GRP) r2_load(S0, P.RG, P.RH, base + c + 2, it, lane); }
    }
    if (ct < 2) { bf16_t* Gd = P.GGRP + (size_t)cg * 4096 + (4 * hi) * 64 + 32 * ct + r32;
#pragma unroll
        for (int jp = 0; jp < 2; ++jp)
#pragma unroll
            for (int r = 0; r < 16; ++r) Gd[(32 * jp + (r & 3) + 8 * (r >> 2)) * 64] = f2bf(Z[jp][r]); }
    else {
#pragma unroll
        for (int jp = 0; jp < 2; ++jp) { const Pk2 p = pk16(Z[jp]); P.HGRP[(((size_t)cg * 4 + jp * 2 + it) * 64 + lane) * 2] = *(const u32x4*)&p.f[0]; P.HGRP[(((size_t)cg * 4 + jp * 2 + it) * 64 + lane) * 2 + 1] = *(const u32x4*)&p.f[1]; } }
}
__device__ __forceinline__ void r2b_item(const Ptrs& P, int witem, int lane) {
    const int chain = witem >> 1, it = witem & 1, r32 = lane & 31, hi = lane >> 5;
    f32x16 Z[2]; Z[0] = f32x16{}; Z[1] = f32x16{};
    const int aoff = r32 * 64 + 4 * hi;
#pragma unroll 1
    for (int g = 0; g < NGRP; ++g) { const size_t cg = (size_t)chain * NGRP + g; const bf16_t* Gc = P.GGRP + cg * 4096;
        u32x2 A[2][2][2][2]; u32x4 Hh[2][2];
#pragma unroll
        for (int jp = 0; jp < 2; ++jp) {
#pragma unroll
            for (int jt = 0; jt < 2; ++jt)
#pragma unroll
                for (int s2 = 0; s2 < 2; ++s2)
#pragma unroll
                    for (int e = 0; e < 2; ++e) A[jp][jt][s2][e] = *(const u32x2*)((Gc + (32 * jp) * 64 + 32 * jt + 16 * s2 + 8 * e) + aoff);
            Hh[jp][0] = P.HGRP[((cg * 4 + jp * 2 + it) * 64 + lane) * 2]; Hh[jp][1] = P.HGRP[((cg * 4 + jp * 2 + it) * 64 + lane) * 2 + 1]; }
        Pk2 z[2]; z[0] = pk16(Z[0]); z[1] = pk16(Z[1]);
#pragma unroll
        for (int jt = 0; jt < 2; ++jt)
#pragma unroll
            for (int s2 = 0; s2 < 2; ++s2) P.ZGRP[(((cg * 2 + jt) * 2 + it) * 2 + s2) * 64 + lane] = *(const u32x4*)&z[jt].f[s2];
#pragma unroll
        for (int jp = 0; jp < 2; ++jp) { f32x16 acc = unpk16(Hh[jp][0], Hh[jp][1]);
#pragma unroll
            for (int jt = 0; jt < 2; ++jt)
#pragma unroll
                for (int s2 = 0; s2 < 2; ++s2) { const u32x4 aw = {A[jp][jt][s2][0].x, A[jp][jt][s2][0].y, A[jp][jt][s2][1].x, A[jp][jt][s2][1].y}; acc = mma(*(const bf16x8*)&aw, z[jt].f[s2], acc); }
            Z[jp] = acc; }
    }
}
struct R3Set { u32x4 R[2][2]; u32x4 Y[2]; };
__device__ __forceinline__ void r3_load(R3Set& T, const u32x4* RRH, const u32x4* RY0, size_t item, int it, int lane) {
#pragma unroll
    for (int jt = 0; jt < 2; ++jt)
#pragma unroll
        for (int s = 0; s < 2; ++s) T.R[jt][s] = RRH[((item * 2 + jt) * 2 + s) * 64 + lane];
    T.Y[0] = RY0[((item * 2 + it) * 64 + lane) * 2]; T.Y[1] = RY0[((item * 2 + it) * 64 + lane) * 2 + 1];
}
__device__ __forceinline__ void r2c_step(const R2Set& S, const R3Set& T, f32x16 (&Z)[2], float* yout) {
    Pk2 z[2]; z[0] = pk16(Z[0]); z[1] = pk16(Z[1]);
    f32x16 y = unpk16(T.Y[0], T.Y[1]);
#pragma unroll
    for (int jt = 0; jt < 2; ++jt)
#pragma unroll
        for (int s = 0; s < 2; ++s) y = mma(*(const bf16x8*)&T.R[jt][s], z[jt].f[s], y);
    if (yout) {
#pragma unroll
        for (int r = 0; r < 16; ++r) yout[((r & 3) + 8 * (r >> 2)) * 512] = y[r]; }
#pragma unroll
    for (int jp = 0; jp < 2; ++jp) { f32x16 acc = unpk16(S.H[jp][0], S.H[jp][1]);
#pragma unroll
        for (int jt = 0; jt < 2; ++jt)
#pragma unroll
            for (int s = 0; s < 2; ++s) acc = mma(*(const bf16x8*)&S.A[jp][jt][s], z[jt].f[s], acc);
        Z[jp] = acc; }
}
__device__ __forceinline__ float* r3_dst(float* Yd, int chain, int chunk, int it, int lane) {
    if (chunk < 8) return nullptr;
    const int h = chain & 7, dir = (chain >> 3) & 1, b = chain >> 4; const int m = dir ? (519 - chunk) : (chunk - 8); const int r32 = lane & 31, hi = lane >> 5;
    return Yd + ((size_t)b * SEQ + 32 * m + 4 * hi) * 512 + h * 64 + 32 * it + r32;
}
__device__ __forceinline__ void r2c_task(const Ptrs& P, int task, int lane) {
    const int it = task & 1, cg = task >> 1; const int chain = cg / NGRP, g = cg - chain * NGRP;
    const size_t base = (size_t)chain * NCH + (size_t)g * GRP;
    float* Yd = ((chain >> 3) & 1) ? P.YRB : P.YR;
    f32x16 Z[2];
#pragma unroll
    for (int jt = 0; jt < 2; ++jt) Z[jt] = unpk16(P.ZGRP[((((size_t)cg * 2 + jt) * 2 + it) * 2 + 0) * 64 + lane], P.ZGRP[((((size_t)cg * 2 + jt) * 2 + it) * 2 + 1) * 64 + lane]);
    R2Set S0, S1; R3Set T0, T1;
    r2_load(S0, P.RG, P.RH, base, it, lane); r3_load(T0, P.RRH, P.RY0, base, it, lane);
#pragma unroll 1
    for (int c = 0; c < GRP; c += 2) {
        r2_load(S1, P.RG, P.RH, base + c + 1, it, lane); r3_load(T1, P.RRH, P.RY0, base + c + 1, it, lane);
        r2c_step(S0, T0, Z, r3_dst(Yd, chain, g * GRP + c, it, lane));
        if (c + 2 < GRP) { r2_load(S0, P.RG, P.RH, base + c + 2, it, lane); r3_load(T0, P.RRH, P.RY0, base + c + 2, it, lane); }
        r2c_step(S1, T1, Z, r3_dst(Yd, chain, g * GRP + c + 1, it, lane));
    }
}

__device__ __forceinline__ void r3_item(const Ptrs& P, int item, int lane) {
    const int m = item & 511, h = (item >> 9) & 7, b = item >> 12, r32 = lane & 31, hi = lane >> 5;
    f32x16 acc[2]; acc[0] = f32x16{}; acc[1] = f32x16{};
#pragma unroll
    for (int dir = 0; dir < 2; ++dir) {
        const int chain = (b * 2 + dir) * 8 + h, chunk = dir ? (8 + 511 - m) : (8 + m); const size_t it_ = (size_t)chain * NCH + chunk;
#pragma unroll
        for (int ti = 0; ti < 2; ++ti) { const f32x16 y0 = unpk16(P.RY0[((it_ * 2 + ti) * 64 + lane) * 2], P.RY0[((it_ * 2 + ti) * 64 + lane) * 2 + 1]);
#pragma unroll
            for (int r = 0; r < 16; ++r) acc[ti][r] += y0[r]; }
#pragma unroll
        for (int tj = 0; tj < 2; ++tj)
#pragma unroll
            for (int s = 0; s < 2; ++s) { const u32x4 a = P.RRH[((it_ * 2 + tj) * 2 + s) * 64 + lane];
#pragma unroll
                for (int ti = 0; ti < 2; ++ti) { const u32x4 z = P.ZS[(((it_ * 2 + tj) * 2 + ti) * 2 + s) * 64 + lane]; acc[ti] = mma(*(const bf16x8*)&a, *(const bf16x8*)&z, acc[ti]); } }
    }
    float* yr = P.YR + ((size_t)b * SEQ + 32 * m + 4 * hi) * 512 + h * 64 + r32;
#pragma unroll
    for (int ti = 0; ti < 2; ++ti)
#pragma unroll
        for (int r = 0; r < 16; ++r) (yr + ((r & 3) + 8 * (r >> 2)) * 512 + 32 * ti)[0] = acc[ti][r];
}
}
typedef const __attribute__((address_space(4))) Args* ArgP;
#define GAS __attribute__((address_space(1)))
struct ArgV { ArgP p; __device__ __forceinline__ const float* operator[](int k) const { return (const float*)(const GAS float*)p->in[k]; } };
struct ArgsView { ArgV in; float* out; };
struct Frame {
    ArgP ap; unsigned char* ws; LAS unsigned char* lds; char* ldsg; int tid, lane, wave, G, bid, probe_skip;
    template <class T> __device__ __forceinline__ T* w(size_t off) const { return (T*)(GAS T*)(ws + off); }
    __device__ __forceinline__ const float* in(int k) const { return (const float*)(const GAS float*)ap->in[k]; }
    __device__ __forceinline__ const float* mod(int l, int v) const { return (const float*)(const GAS float*)(ws + WS_MOD) + (size_t)(l * 3 + v) * 6144; }
};

struct CvtJob { const float* src; bf16_t* dst; const float* rowscale; int ldn, Kvalid, Nvalid, koff, Kd, Nd, ldk, mode, nbatch; size_t sbstride, dbstride; int fp8; };
__device__ __forceinline__ CvtJob get_job(const Frame& F, int j) {
    CvtJob J; J.rowscale = nullptr; J.koff = 0; J.mode = 0; J.nbatch = 1; J.sbstride = 0; J.dbstride = 0; J.fp8 = 0;
    const ArgsView a{ArgV{F.ap}, (float*)(GAS float*)F.ap->out};
    switch (j) {
    case 0: J.src = a.in[I_WIN]; J.dst = F.w<bf16_t>(WS_WIN); J.ldn = 2176; J.Kvalid = 1024; J.Nvalid = 2176; J.Kd = 1024; J.Nd = PW; J.ldk = 1024; break;
    case 1: J.src = a.in[I_WUQ]; J.dst = F.w<bf16_t>(WS_WUQ); J.rowscale = a.in[I_QNORM]; J.ldn = 768; J.Kvalid = 256; J.Nvalid = 768; J.Kd = 256; J.Nd = 768; J.ldk = 256; break;
    case 2: J.src = a.in[I_WUKV]; J.dst = F.w<bf16_t>(WS_WUKV); J.rowscale = a.in[I_KVNORM]; J.ldn = 1024; J.Kvalid = 128; J.Nvalid = 1024; J.Kd = 128; J.Nd = 1024; J.ldk = 128; break;
    case 3: case 4: case 5: case 6: { const int which = j - 3, d = which & 1;
        J.src = (which < 2 ? a.in[I_W2] : a.in[I_A2]) + (size_t)d * 32 * 512; J.dst = F.w<bf16_t>(WS_WLORA) + (size_t)which * 512 * 128;
        J.ldn = 512; J.Kvalid = 32; J.Nvalid = 512; J.koff = which * 32; J.Kd = 128; J.Nd = 512; J.ldk = 128; break; }
    case 7: J.src = a.in[I_G2]; J.dst = F.w<bf16_t>(WS_WG2); J.ldn = 512; J.Kvalid = 96; J.Nvalid = 512; J.Kd = 128; J.Nd = 512; J.ldk = 128; break;
    case 8: J.src = a.in[I_WOUT]; J.dst = F.w<bf16_t>(WS_WOUT); J.ldn = 1024; J.Kvalid = 1024; J.Nvalid = 1024; J.Kd = 1024; J.Nd = 1024; J.ldk = 1024; break;
    case 9: J.src = a.in[I_GMIN]; J.dst = F.w<bf16_t>(WS_WGMIN); J.ldn = 2048; J.Kvalid = 1024; J.Nvalid = 2048; J.Kd = 1024; J.Nd = 2048; J.ldk = 1024; J.fp8 = 1; break;
    case 10: J.src = a.in[I_GMOUT]; J.dst = F.w<bf16_t>(WS_WGMOUT); J.ldn = 1024; J.Kvalid = 1024; J.Nvalid = 1024; J.Kd = 1024; J.Nd = 1024; J.ldk = 1024; J.fp8 = 1; break;
    case 11: J.src = a.in[I_WGU]; J.dst = F.w<bf16_t>(WS_WGU); J.ldn = 2048; J.Kvalid = 1024; J.Nvalid = 2048; J.Kd = 1024; J.Nd = 2048; J.ldk = 1024; J.mode = 1; J.nbatch = 64;
        J.sbstride = (size_t)1024 * 2048; J.dbstride = (size_t)2048 * 1024; J.fp8 = 1; break;
    default: J.src = a.in[I_WDN]; J.dst = F.w<bf16_t>(WS_WDN); J.ldn = 1024; J.Kvalid = 1024; J.Nvalid = 1024; J.Kd = 1024; J.Nd = 1024; J.ldk = 1024; J.nbatch = 64;
        J.sbstride = (size_t)1024 * 1024; J.dbstride = (size_t)1024 * 1024; J.fp8 = 1; break;
    }
    return J;
}
constexpr int NJOBS = 13;
__device__ __forceinline__ void cvt_tile(const CvtJob& J, int tile, LAS float* tl  , int tid) {
    const int tk = J.Kd / 64, tn = J.Nd / 64, per = tk * tn; const int bi = tile / per, r = tile - bi * per; const int k0 = (r % tk) * 64, n0 = (r / tk) * 64;
    const float* src = J.src + (size_t)bi * J.sbstride; bf16_t* dst = J.dst + (size_t)bi * J.dbstride;
    __syncthreads();
#pragma unroll
    for (int p = 0; p < 2; ++p) { const int kk = (tid >> 4) + p * 32, c4 = (tid & 15) * 4; const int ks = k0 + kk - J.koff, n = n0 + c4;
        f32x4 v = {0.f, 0.f, 0.f, 0.f};
        if (ks >= 0 && ks < J.Kvalid && n < J.Nvalid) { v = *(const f32x4*)(src + (size_t)ks * J.ldn + n); if (J.rowscale) { const float s = J.rowscale[ks]; v *= s; } }
        tl[kk * 65 + c4] = v[0]; tl[kk * 65 + c4 + 1] = v[1]; tl[kk * 65 + c4 + 2] = v[2]; tl[kk * 65 + c4 + 3] = v[3]; }
    __syncthreads();
    { const int n = tid >> 3, k8 = (tid & 7) * 8; float f[8];
#pragma unroll
      for (int i = 0; i < 8; ++i) f[i] = tl[(k8 + i) * 65 + n];
      int nn = n0 + n; if (J.mode == 1) nn = (nn < 1024) ? ((nn >> 7) * 256 + (nn & 127)) : ((((nn - 1024) >> 7) * 256) + 128 + ((nn - 1024) & 127));
      *(u32x4*)(dst + (size_t)nn * J.ldk + k0 + k8) = pack8(f); }
}
__device__ __forceinline__ void cvt_tile_wave(const CvtJob& J, int tile, LAS float* tl, int lane) {
    const int tk = J.Kd / 64, tn = J.Nd / 64, per = tk * tn; const int bi = tile / per, r = tile - bi * per; const int k0 = (r % tk) * 64, n0 = (r / tk) * 64;
    const float* src = J.src + (size_t)bi * J.sbstride; bf16_t* dst = J.dst + (J.fp8 ? 0 : (size_t)bi * J.dbstride); unsigned char* dst8 = (unsigned char*)J.dst + (size_t)bi * J.dbstride;
    const int c4 = (lane & 15) * 4, n = n0 + c4;
    f32x4 v[16];
#pragma unroll
    for (int p = 0; p < 16; ++p) { const int kk = (lane >> 4) + 4 * p; const int ks = k0 + kk - J.koff;
        v[p] = (f32x4){0.f, 0.f, 0.f, 0.f};
        if (ks >= 0 && ks < J.Kvalid && n < J.Nvalid) { v[p] = *(const f32x4*)(src + (size_t)ks * J.ldn + n); if (J.rowscale) { const float s = J.rowscale[ks]; v[p] *= s; } } }
#pragma unroll
    for (int p = 0; p < 16; ++p) { const int kk = (lane >> 4) + 4 * p; tl[kk * 65 + c4] = v[p][0]; tl[kk * 65 + c4 + 1] = v[p][1]; tl[kk * 65 + c4 + 2] = v[p][2]; tl[kk * 65 + c4 + 3] = v[p][3]; }
#pragma unroll
    for (int p = 0; p < 8; ++p) { const int nl = (lane >> 3) + 8 * p, k8 = (lane & 7) * 8; float f[8];
#pragma unroll
        for (int i = 0; i < 8; ++i) f[i] = tl[(k8 + i) * 65 + nl];
        int nn = n0 + nl; if (J.mode == 1) nn = (nn < 1024) ? ((nn >> 7) * 256 + (nn & 127)) : ((((nn - 1024) >> 7) * 256) + 128 + ((nn - 1024) & 127));
        if (J.fp8) *(u32x2*)(dst8 + (size_t)nn * J.ldk + k0 + k8) = pack8_fp8(f, FP8_W_SCALE); else *(u32x4*)(dst + (size_t)nn * J.ldk + k0 + k8) = pack8(f); }
}
struct MoeTile { const float* src; unsigned char* dst; int ncols, n0, k0, swiglu; };
__device__ __forceinline__ MoeTile moe_tile(const float* wgu, const float* wdn, unsigned char* dgu, unsigned char* ddn, int t) {
    MoeTile T; const bool gu = t < 32768; const int tt = gu ? t : t - 32768; T.ncols = gu ? 2048 : 1024; T.swiglu = gu ? 1 : 0;
    const int tn = T.ncols / 64, per = 16 * tn; const int bi = tt / per, r = tt - bi * per; T.k0 = (r & 15) * 64; T.n0 = (r >> 4) * 64;
    T.src = (gu ? wgu : wdn) + (size_t)bi * 1024 * T.ncols; T.dst = (gu ? dgu : ddn) + (size_t)bi * T.ncols * 1024; return T; }
__device__ __forceinline__ void moe_tile_load(const MoeTile& T, int lane, f32x4 (&v)[16]) { const int c4 = (lane & 15) * 4;
#pragma unroll
    for (int p = 0; p < 16; ++p) { const int kk = (lane >> 4) + 4 * p; v[p] = __builtin_nontemporal_load((const f32x4*)(T.src + (size_t)(T.k0 + kk) * T.ncols + T.n0 + c4)); } }
__device__ __forceinline__ void moe_tile_store(const MoeTile& T, int lane, const f32x4 (&v)[16], LAS float* tl) { const int c4 = (lane & 15) * 4;
#pragma unroll
    for (int p = 0; p < 16; ++p) { const int kk = (lane >> 4) + 4 * p; tl[kk * 65 + c4] = v[p][0]; tl[kk * 65 + c4 + 1] = v[p][1]; tl[kk * 65 + c4 + 2] = v[p][2]; tl[kk * 65 + c4 + 3] = v[p][3]; }
#pragma unroll
    for (int p = 0; p < 8; ++p) { const int nl = (lane >> 3) + 8 * p, k8 = (lane & 7) * 8; float f[8];
#pragma unroll
        for (int i = 0; i < 8; ++i) f[i] = tl[(k8 + i) * 65 + nl];
        int nn = T.n0 + nl; if (T.swiglu) nn = (nn < 1024) ? ((nn >> 7) * 256 + (nn & 127)) : ((((nn - 1024) >> 7) * 256) + 128 + ((nn - 1024) & 127));
        *(u32x2*)(T.dst + (size_t)nn * 1024 + T.k0 + k8) = pack8_fp8(f, FP8_W_SCALE); } }
__device__ __forceinline__ void cvt_moe_weights(const Frame& F, int cid, int nconv, int ldsoff) {
    LAS float* tl = (LAS float*)(F.lds + ldsoff);
    const float* wgu = F.in(I_WGU); const float* wdn = F.in(I_WDN); unsigned char* dgu = F.w<unsigned char>(WS_WGU); unsigned char* ddn = F.w<unsigned char>(WS_WDN);
    constexpr int NT = 32768 + 16384;
    f32x4 va[16], vb[16]; int t = cid; if (t >= NT) return;
    MoeTile Ta = moe_tile(wgu, wdn, dgu, ddn, t), Tb = Ta; moe_tile_load(Ta, F.lane, va);
    for (;;) {
        const int t1 = t + nconv; if (t1 < NT) { Tb = moe_tile(wgu, wdn, dgu, ddn, t1); moe_tile_load(Tb, F.lane, vb); }
        moe_tile_store(Ta, F.lane, va, tl); if (t1 >= NT) break;
        const int t2 = t1 + nconv; if (t2 < NT) { Ta = moe_tile(wgu, wdn, dgu, ddn, t2); moe_tile_load(Ta, F.lane, va); }
        moe_tile_store(Tb, F.lane, vb, tl); if (t2 >= NT) break;
        t = t2;
    }
}
__device__ __forceinline__ void phase_prologue(const Frame& F) {
    const ArgsView a{ArgV{F.ap}, (float*)(GAS float*)F.ap->out}; const int tid = F.tid;
    LAS float* lf = (LAS float*)F.lds;
    for (int item = F.bid; item < 192; item += F.G) {
        const int l = item / 96, nb = item - l * 96; const int cg = tid & 15, ks = tid >> 4;
        const float* W = a.in[I_ADAW] + (size_t)l * 1024 * 6144 + nb * 64 + cg * 4;
        __syncthreads();
        for (int i = tid; i < 3072; i += 512) { const float c = i < 2048 ? a.in[I_C][i] : a.in[I_CCTX][i - 2048]; lf[8192 + i] = c * sigmoidf_(c); }
        __syncthreads();
        f32x4 acc0 = {0, 0, 0, 0}, acc1 = acc0, acc2 = acc0;
#pragma unroll 8
        for (int k = ks * 32; k < ks * 32 + 32; ++k) { const f32x4 w = *(const f32x4*)(W + (size_t)k * 6144);
            acc0 += w * lf[8192 + k]; acc1 += w * lf[8192 + 1024 + k]; acc2 += w * lf[8192 + 2048 + k]; }
#pragma unroll
        for (int q = 0; q < 4; ++q) { lf[(ks * 3 + 0) * 64 + cg * 4 + q] = acc0[q]; lf[(ks * 3 + 1) * 64 + cg * 4 + q] = acc1[q]; lf[(ks * 3 + 2) * 64 + cg * 4 + q] = acc2[q]; }
        __syncthreads();
        if (tid < 192) { const int v = tid >> 6, col = tid & 63; float s = 0.f;
            for (int k2 = 0; k2 < 32; ++k2) s += lf[(k2 * 3 + v) * 64 + col];
            F.w<float>(WS_MOD)[(size_t)(l * 3 + v) * 6144 + nb * 64 + col] = s + a.in[I_ADAB][l * 6144 + nb * 64 + col]; }
    }
    for (int i = F.bid * 512 + tid; i < 2048; i += F.G * 512) { const int pos = i >> 3, f = i & 7; const float inv = powf(10000.0f, -(float)f / 8.0f); float s, c; sincosf((float)pos * inv, &s, &c);
        F.w<float>(WS_ROPE)[2 * i] = c; F.w<float>(WS_ROPE)[2 * i + 1] = s; }
    for (int i = F.bid * 512 + tid; i < 8 * 128 * 128 / 8; i += F.G * 512) { const f32x4 x0 = *(const f32x4*)(a.in[I_GMWS] + (size_t)i * 8), x1 = *(const f32x4*)(a.in[I_GMWS] + (size_t)i * 8 + 4);
        const float f[8] = {x0[0], x0[1], x0[2], x0[3], x1[0], x1[1], x1[2], x1[3]}; *(u32x4*)(F.w<bf16_t>(WS_WS) + (size_t)i * 8) = pack8(f); }
    __syncthreads();
    { LAS float* tl = (LAS float*)(F.lds + F.wave * 16640); const int nw = F.G * 8, gw = F.bid * 8 + F.wave; int base = 0;
      for (int j = 0; j < 11; ++j) { const CvtJob J = get_job(F, j); const int nt = (J.Kd / 64) * (J.Nd / 64) * J.nbatch;
          const int first = (gw - base % nw + nw) % nw;
          for (int t = first; t < nt; t += nw) cvt_tile_wave(J, t, tl, F.lane);
          base += nt; } }
    __syncthreads();
}

__device__ __forceinline__ void phase_h0(const Frame& F) {
    const ArgsView a{ArgV{F.ap}, (float*)(GAS float*)F.ap->out}; const int lane = F.lane; bf16_t* H = F.w<bf16_t>(WS_H);
    const float* g = a.in[I_NMPRE];
    float hA[16], hB[16]; int ck = -1;
    f32x4 nx[4];
#define H0_LOAD(r_) do { const int b_ = (r_) / SB, rr_ = (r_) - b_ * SB; const float* xp_ = rr_ < CTXL ? a.in[I_CTX] + ((size_t)b_ * CTXL + rr_) * 1024 : a.in[I_X] + ((size_t)b_ * SEQ + (rr_ - CTXL)) * 1024; \
        _Pragma("unroll") for (int hb = 0; hb < 2; ++hb) { nx[hb * 2] = *(const f32x4*)(xp_ + hb * 512 + lane * 8); nx[hb * 2 + 1] = *(const f32x4*)(xp_ + hb * 512 + lane * 8 + 4); } } while (0)
    if (F.bid * 8 + F.wave < NR) H0_LOAD(F.bid * 8 + F.wave);
    for (int row = F.bid * 8 + F.wave; row < NR; row += F.G * 8) {
        const int b = row / SB, rr = row - b * SB; const bool isctx = rr < CTXL;
        const int key = isctx ? 2 : b;
        if (key != ck) { ck = key; const float* md = F.mod(0, key);
#pragma unroll
            for (int hb = 0; hb < 2; ++hb) { const int c0 = hb * 512 + lane * 8;
#pragma unroll
                for (int q = 0; q < 8; ++q) { hA[hb * 8 + q] = g[c0 + q] * (1.0f + md[1024 + c0 + q]); hB[hb * 8 + q] = md[c0 + q]; } } }
        float x[16]; float ss = 0.f;
#pragma unroll
        for (int hb = 0; hb < 2; ++hb) { const f32x4 v0 = nx[hb * 2], v1 = nx[hb * 2 + 1];
#pragma unroll
            for (int q = 0; q < 4; ++q) { x[hb * 8 + q] = v0[q]; x[hb * 8 + 4 + q] = v1[q]; ss += v0[q] * v0[q] + v1[q] * v1[q]; } }
        if (row + F.G * 8 < NR) H0_LOAD(row + F.G * 8);
        ss = wave_sum(ss); const float rstd = __builtin_amdgcn_rsqf(ss * (1.0f / 1024.0f) + EPSF);
#pragma unroll
        for (int hb = 0; hb < 2; ++hb) { const int c0 = hb * 512 + lane * 8; float o[8];
#pragma unroll
            for (int q = 0; q < 8; ++q) o[q] = x[hb * 8 + q] * rstd * hA[hb * 8 + q] + hB[hb * 8 + q];
            *(u32x4*)(H + (size_t)row * 1024 + c0) = pack8(o); }
    }
#undef H0_LOAD
}

__device__ __forceinline__ void phase_rwprep(const Frame& F) {
    const ArgsView a{ArgV{F.ap}, (float*)(GAS float*)F.ap->out}; const int lane = F.lane; const bf16_t* P = F.w<bf16_t>(WS_P);
    const float* mup = a.in[I_MUP]; const float* mun = a.in[I_MUN]; const float* kkw = a.in[I_KK]; const float* rope = F.w<float>(WS_ROPE);
    bf16_t* RWR = F.w<bf16_t>(WS_RWR); bf16_t* RWK = F.w<bf16_t>(WS_RWK); bf16_t* RWV = F.w<bf16_t>(WS_RWV); bf16_t* RWKK = F.w<bf16_t>(WS_RWKK);
    bf16_t* LA = F.w<bf16_t>(WS_LA); bf16_t* GA = F.w<bf16_t>(WS_GA); bf16_t* Kb = F.w<bf16_t>(WS_K);
    float mp[4][8], mn_[4][8], kkc[8];
#pragma unroll
    for (int round = 0; round < 4; ++round) { const int ch = round * 64 + lane;
#pragma unroll
        for (int q = 0; q < 8; ++q) { mp[round][q] = ch < 220 ? mup[ch * 8 + q] : 0.f; mn_[round][q] = ch < 220 ? mun[ch * 8 + q] : 0.f; } }
#pragma unroll
    for (int q = 0; q < 8; ++q) kkc[q] = kkw[lane * 8 + q];
    for (int row = F.bid * 8 + F.wave; row < NR; row += F.G * 8) {
        const int b = row / SB, rr = row - b * SB; const bool hasprev = (rr != 0 && rr != CTXL), hasnext = (rr != CTXL - 1 && rr != SB - 1);
        const bf16_t* pc = P + (size_t)row * PW + 416;
        u32x4 lp[4], lpp[4], lpn[4];
        const u32x4 z4 = {0u, 0u, 0u, 0u};
#pragma unroll
        for (int round = 0; round < 4; ++round) { const int ch = round * 64 + lane; lp[round] = z4; lpp[round] = z4; lpn[round] = z4;
            if (ch < 220) { lp[round] = *(const u32x4*)(pc + ch * 8); if (hasprev) lpp[round] = *(const u32x4*)(pc - PW + ch * 8); if (hasnext) lpn[round] = *(const u32x4*)(pc + PW + ch * 8); } }
        const u32x4 lrope = *(const u32x4*)(P + (size_t)row * PW + 384 + (lane & 3) * 8);
#pragma unroll
        for (int round = 0; round < 4; ++round) {
            const int ch = round * 64 + lane;
            if (ch < 220) {
                float p[8], pp[8], pn[8], s[8];
                unpack8(lp[round], p); unpack8(lpp[round], pp); unpack8(lpn[round], pn);
#pragma unroll
                for (int q = 0; q < 8; ++q) s[q] = p[q] + mp[round][q] * (pp[q] - p[q]) + mn_[round][q] * (pn[q] - p[q]);
                if (round < 3) {
                    const size_t o = ((size_t)(b * 8 + (lane >> 3)) * SB + rr) * 64 + (lane & 7) * 8;
                    bf16_t* dst = round == 0 ? RWR : (round == 1 ? RWK : RWV);
                    *(u32x4*)(dst + o) = pack8(s);
                    if (round == 1) { float x[8]; float ss = 0.f;
#pragma unroll
                        for (int q = 0; q < 8; ++q) { x[q] = s[q] * kkc[q]; ss += x[q] * x[q]; }
                        ss += __shfl_xor(ss, 1); ss += __shfl_xor(ss, 2); ss += __shfl_xor(ss, 4);
                        const float rn = __builtin_amdgcn_rsqf(fmaxf(ss, 1e-24f));
#pragma unroll
                        for (int q = 0; q < 8; ++q) x[q] *= rn;
                        *(u32x4*)(RWKK + o) = pack8(x); }
                } else {
                    const int cc = lane * 8;
                    if (cc < 64) {
#pragma unroll
                        for (int q = 0; q < 8; ++q) s[q] = tanhf(s[q]);
                        *(u32x4*)(LA + (size_t)row * 128 + cc) = pack8(s);
                    } else if (cc < 128) { *(u32x4*)(LA + (size_t)row * 128 + cc) = pack8(s);
                    } else {
#pragma unroll
                        for (int q = 0; q < 8; ++q) s[q] = sigmoidf_(s[q]);
                        *(u32x4*)(GA + (size_t)row * 128 + (cc - 128)) = pack8(s); }
                }
            } else if (round == 3 && lane < 32) { const float z[8] = {0, 0, 0, 0, 0, 0, 0, 0}; *(u32x4*)(GA + (size_t)row * 128 + 96 + (lane - 28) * 8) = pack8(z); }
        }
        {
            const int q4 = lane & 3; float v[8]; unpack8(lrope, v);
            if (rr >= CTXL) { const int t = rr - CTXL, axis = q4 >> 1, half = q4 & 1; const int pos = axis ? (t & 63) : (t >> 6); const float* tb = rope + pos * 16;
#pragma unroll
                for (int j = 0; j < 8; ++j) { const float pv = __shfl_xor(v[j], 1); const float cs = tb[2 * j], sn = tb[2 * j + 1]; v[j] = half ? (v[j] * cs + pv * sn) : (v[j] * cs - pv * sn); } }
            const int hd = lane >> 3;
            if (lane < 32) *(u32x4*)(Kb + ((size_t)(b * 8 + (lane >> 2)) * SB + rr) * 96 + 64 + q4 * 8) = pack8(v);
            (void)hd;
        }
    }
}

__device__ __forceinline__ void phase_readout(const Frame& F) {
    const ArgsView a{ArgV{F.ap}, (float*)(GAS float*)F.ap->out}; const int lane = F.lane; const float* YR = F.w<float>(WS_YR); const float* YRB = F.w<float>(WS_YRB);
    const bf16_t* RWR = F.w<bf16_t>(WS_RWR); const bf16_t* RWK = F.w<bf16_t>(WS_RWK); const bf16_t* RWV = F.w<bf16_t>(WS_RWV); const bf16_t* GG = F.w<bf16_t>(WS_GG);
    bf16_t* MIX = F.w<bf16_t>(WS_MIX);
    const int h = lane >> 3, j8 = (lane & 7) * 8, ch = lane * 8;
    float lw[8], lb[8], rk[8];
#pragma unroll
    for (int q = 0; q < 8; ++q) { lw[q] = a.in[I_LNW][ch + q]; lb[q] = a.in[I_LNB][ch + q]; rk[q] = a.in[I_RK][ch + q]; }
    f32x4 ny0, ny1, nz0, nz1; u32x4 nr, nk, nv, ng;
#define RO_LOAD(t_) do { const int b_ = (t_) / SEQ, rr_ = CTXL + (t_) - b_ * SEQ; const size_t o_ = ((size_t)(b_ * 8 + h) * SB + rr_) * 64 + j8; \
        ny0 = *(const f32x4*)(YR + (size_t)(t_) * 512 + ch); ny1 = *(const f32x4*)(YR + (size_t)(t_) * 512 + ch + 4); nz0 = *(const f32x4*)(YRB + (size_t)(t_) * 512 + ch); nz1 = *(const f32x4*)(YRB + (size_t)(t_) * 512 + ch + 4); nr = *(const u32x4*)(RWR + o_); nk = *(const u32x4*)(RWK + o_); nv = *(const u32x4*)(RWV + o_); \
        ng = *(const u32x4*)(GG + ((size_t)b_ * SB + rr_) * 512 + ch); } while (0)
    if (F.bid * 8 + F.wave < NL) RO_LOAD(F.bid * 8 + F.wave);
    for (int tok = F.bid * 8 + F.wave; tok < NL; tok += F.G * 8) {
        float y[8]; { const f32x4 y0 = ny0 + nz0, y1 = ny1 + nz1;
#pragma unroll
            for (int q = 0; q < 4; ++q) { y[q] = y0[q]; y[4 + q] = y1[q]; } }
        float r[8], k[8], v[8], g[8]; unpack8(nr, r); unpack8(nk, k); unpack8(nv, v); unpack8(ng, g);
        if (tok + F.G * 8 < NL) RO_LOAD(tok + F.G * 8);
        float sm = 0.f;
#pragma unroll
        for (int q = 0; q < 8; ++q) sm += y[q];
        sm += __shfl_xor(sm, 1); sm += __shfl_xor(sm, 2); sm += __shfl_xor(sm, 4); const float mu = sm * (1.0f / 64.0f);
        float vs = 0.f;
#pragma unroll
        for (int q = 0; q < 8; ++q) { y[q] -= mu; vs += y[q] * y[q]; }
        vs += __shfl_xor(vs, 1); vs += __shfl_xor(vs, 2); vs += __shfl_xor(vs, 4); const float rstd = __builtin_amdgcn_rsqf(vs * (1.0f / 64.0f) + 64e-5f);
        float bs = 0.f;
#pragma unroll
        for (int q = 0; q < 8; ++q) bs += r[q] * k[q] * rk[q];
        bs += __shfl_xor(bs, 1); bs += __shfl_xor(bs, 2); bs += __shfl_xor(bs, 4);
        float o8[8];
#pragma unroll
        for (int q = 0; q < 8; ++q) o8[q] = (y[q] * rstd * lw[q] + lb[q] + bs * v[q]) * g[q];
        *(u32x4*)(MIX + (size_t)tok * 1024 + 512 + ch) = pack8(o8);
    }
#undef RO_LOAD
}
__device__ __forceinline__ void phase_postmix(const Frame& F, int l) {
    const ArgsView a{ArgV{F.ap}, (float*)(GAS float*)F.ap->out}; const int lane = F.lane, tid = F.tid;
    LAS float* Wr = (LAS float*)F.lds; LAS int* hist = (LAS int*)(F.lds + 131072);
    const float* rw = a.in[I_RW] + (size_t)l * 1024 * 32;
    __syncthreads();
    { f32x4 wv[16];
#pragma unroll
      for (int k = 0; k < 16; ++k) wv[k] = *(const f32x4*)(rw + (size_t)(k * 512 + tid) * 4);
#pragma unroll
      for (int k = 0; k < 16; ++k) { const int i0 = (k * 512 + tid) * 4; const int c = i0 >> 5, e0 = i0 & 31; const int hb = c >> 9, ln = (c & 511) >> 3, q8 = c & 7;
#pragma unroll
          for (int q = 0; q < 4; ++q) Wr[(((e0 + q) * 4 + hb * 2 + (q8 >> 2)) * 64 + ln) * 4 + (q8 & 3)] = wv[k][q]; } }
    if (tid < 32) hist[tid] = 0;
    __syncthreads();
    const float* xin = a.in[I_X]; bf16_t* X1 = F.w<bf16_t>(WS_X1);     const bf16_t* Y = F.w<bf16_t>(WS_Y); unsigned char* HF = F.w<unsigned char>(WS_HF);
    const float* gpost = a.in[I_NMPOST] + l * 1024; const float* gffn = a.in[I_NFPRE] + l * 1024; const float rbias = a.in[I_RB][l * 32 + (((lane >> 5) & 1) * 16 + ((lane >> 4) & 1) * 8 + ((lane >> 3) & 1) * 4 + ((lane >> 2) & 1) * 2 + ((lane >> 1) & 1))];
    const int myexp = ((lane >> 5) & 1) * 16 + ((lane >> 4) & 1) * 8 + ((lane >> 3) & 1) * 4 + ((lane >> 2) & 1) * 2 + ((lane >> 1) & 1);
    const int tpb = (NL + F.G - 1) / F.G; const int t0 = F.bid * tpb, t1 = (t0 + tpb < NL) ? t0 + tpb : NL;
    float gA[16], gB[16], gC[16]; int cb = -1;
    f32x4 nx[4]; u32x4 ny[2];
#define PM_LOAD(t) do { _Pragma("unroll") for (int hb = 0; hb < 2; ++hb) { const int c0 = hb * 512 + lane * 8; \
        if (l == 0) { nx[hb * 2] = *(const f32x4*)(xin + (size_t)(t) * 1024 + c0); nx[hb * 2 + 1] = *(const f32x4*)(xin + (size_t)(t) * 1024 + c0 + 4); } \
        else { const u32x4 w_ = *(const u32x4*)(X1 + (size_t)(t) * 1024 + c0); nx[hb * 2] = *(const f32x4*)&w_; } \
        ny[hb] = *(const u32x4*)(Y + (size_t)(t) * 1024 + c0); } } while (0)
    if (t0 + F.wave < t1) PM_LOAD(t0 + F.wave);
    for (int tok0 = t0 + F.wave; tok0 < t1; tok0 += 16) {
        float hfA[16], hfB[16]; const bool hasB = tok0 + 8 < t1;
#pragma unroll
        for (int hb = 0; hb < 16; ++hb) hfB[hb] = 0.f;
        { const int tok = tok0;
        const int b = tok / SEQ;
        if (b != cb) { cb = b; const float* md = F.mod(l, b);
#pragma unroll
            for (int hb = 0; hb < 2; ++hb) { const int c0 = hb * 512 + lane * 8;
#pragma unroll
                for (int q = 0; q < 8; ++q) { gA[hb * 8 + q] = md[2048 + c0 + q] * gpost[c0 + q]; gB[hb * 8 + q] = gffn[c0 + q] * (1.0f + md[4096 + c0 + q]); gC[hb * 8 + q] = md[3072 + c0 + q]; } } }
        float x[16], y[16]; float ss = 0.f;
#pragma unroll
        for (int hb = 0; hb < 2; ++hb) { const f32x4 v0 = nx[hb * 2], v1 = nx[hb * 2 + 1];
            float yy[8]; unpack8(ny[hb], yy); float xx[8]; if (l != 0) unpack8(*(const u32x4*)&v0, xx);
#pragma unroll
            for (int q = 0; q < 8; ++q) { x[hb * 8 + q] = (l != 0) ? xx[q] : (q < 4 ? v0[q & 3] : v1[q & 3]); y[hb * 8 + q] = yy[q]; ss += yy[q] * yy[q]; } }
        if (tok + 8 < t1) PM_LOAD(tok + 8);
        ss = wave_sum(ss); const float rstd = __builtin_amdgcn_rsqf(ss * (1.0f / 1024.0f) + EPSF);
        float s1 = 0.f;
#pragma unroll
        for (int hb = 0; hb < 2; ++hb) { const int c0 = hb * 512 + lane * 8;
#pragma unroll
            for (int q = 0; q < 8; ++q) { const float v = x[hb * 8 + q] + gA[hb * 8 + q] * (y[hb * 8 + q] * rstd); x[hb * 8 + q] = v; s1 += v * v; }
            *(u32x4*)(X1 + (size_t)tok * 1024 + c0) = pack8(*(const float (*)[8])&x[hb * 8]); }
        s1 = wave_sum(s1); const float rstd1 = __builtin_amdgcn_rsqf(s1 * (1.0f / 1024.0f) + EPSF);

#pragma unroll
        for (int hb = 0; hb < 2; ++hb) { const int c0 = hb * 512 + lane * 8; float o[8];
#pragma unroll
            for (int q = 0; q < 8; ++q) { o[q] = x[hb * 8 + q] * rstd1 * gB[hb * 8 + q] + gC[hb * 8 + q]; hfA[hb * 8 + q] = o[q]; }
            *(u32x2*)(HF + (size_t)tok * 1024 + c0) = pack8_fp8(o, FP8_ACT_SCALE); }
        }
        if (hasB) { const int tok = tok0 + 8;
        const int b = tok / SEQ;
        if (b != cb) { cb = b; const float* md = F.mod(l, b);
#pragma unroll
            for (int hb = 0; hb < 2; ++hb) { const int c0 = hb * 512 + lane * 8;
#pragma unroll
                for (int q = 0; q < 8; ++q) { gA[hb * 8 + q] = md[2048 + c0 + q] * gpost[c0 + q]; gB[hb * 8 + q] = gffn[c0 + q] * (1.0f + md[4096 + c0 + q]); gC[hb * 8 + q] = md[3072 + c0 + q]; } } }
        float x[16], y[16]; float ss = 0.f;
#pragma unroll
        for (int hb = 0; hb < 2; ++hb) { const f32x4 v0 = nx[hb * 2], v1 = nx[hb * 2 + 1];
            float yy[8]; unpack8(ny[hb], yy); float xx[8]; if (l != 0) unpack8(*(const u32x4*)&v0, xx);
#pragma unroll
            for (int q = 0; q < 8; ++q) { x[hb * 8 + q] = (l != 0) ? xx[q] : (q < 4 ? v0[q & 3] : v1[q & 3]); y[hb * 8 + q] = yy[q]; ss += yy[q] * yy[q]; } }
        if (tok + 8 < t1) PM_LOAD(tok + 8);
        ss = wave_sum(ss); const float rstd = __builtin_amdgcn_rsqf(ss * (1.0f / 1024.0f) + EPSF);
        float s1 = 0.f;
#pragma unroll
        for (int hb = 0; hb < 2; ++hb) { const int c0 = hb * 512 + lane * 8;
#pragma unroll
            for (int q = 0; q < 8; ++q) { const float v = x[hb * 8 + q] + gA[hb * 8 + q] * (y[hb * 8 + q] * rstd); x[hb * 8 + q] = v; s1 += v * v; }
            *(u32x4*)(X1 + (size_t)tok * 1024 + c0) = pack8(*(const float (*)[8])&x[hb * 8]); }
        s1 = wave_sum(s1); const float rstd1 = __builtin_amdgcn_rsqf(s1 * (1.0f / 1024.0f) + EPSF);

#pragma unroll
        for (int hb = 0; hb < 2; ++hb) { const int c0 = hb * 512 + lane * 8; float o[8];
#pragma unroll
            for (int q = 0; q < 8; ++q) { o[q] = x[hb * 8 + q] * rstd1 * gB[hb * 8 + q] + gC[hb * 8 + q]; hfB[hb * 8 + q] = o[q]; }
            *(u32x2*)(HF + (size_t)tok * 1024 + c0) = pack8_fp8(o, FP8_ACT_SCALE); }
        }
        float pA[16], pB[16];
#pragma unroll
        for (int e = 0; e < 16; ++e) { float a0 = 0.f, a1 = 0.f, c0_ = 0.f, c1_ = 0.f;
#pragma unroll
            for (int part = 0; part < 4; ++part) { const f32x4 w = *(const LAS f32x4*)(Wr + ((e * 4 + part) * 64 + lane) * 4), w2 = *(const LAS f32x4*)(Wr + (((e + 16) * 4 + part) * 64 + lane) * 4);
#pragma unroll
                for (int q = 0; q < 4; ++q) { a0 = fmaf(hfA[part * 4 + q], w[q], a0); a1 = fmaf(hfA[part * 4 + q], w2[q], a1); c0_ = fmaf(hfB[part * 4 + q], w[q], c0_); c1_ = fmaf(hfB[part * 4 + q], w2[q], c1_); } }
            const bool up = (lane >> 5) & 1;
            pA[e] = (up ? a1 : a0) + __shfl_xor(up ? a0 : a1, 32); pB[e] = (up ? c1_ : c0_) + __shfl_xor(up ? c0_ : c1_, 32);
            __builtin_amdgcn_sched_barrier(0); }
#pragma unroll 1
        for (int which = 0; which < 2; ++which) { if (which == 1 && !hasB) break; const int tok = tok0 + which * 8;
            float p[16];
#pragma unroll
            for (int e = 0; e < 16; ++e) p[e] = which ? pB[e] : pA[e];
#define RS_STEP(N, OFF, BIT) { _Pragma("unroll") for (int e = 0; e < N; ++e) { const bool up = (lane >> BIT) & 1; const float mine = up ? p[e + N] : p[e]; const float oth = up ? p[e] : p[e + N]; p[e] = mine + __shfl_xor(oth, OFF); } }
        RS_STEP(8, 16, 4) RS_STEP(4, 8, 3) RS_STEP(2, 4, 2) RS_STEP(1, 2, 1)
#undef RS_STEP
        float logit = p[0] + __shfl_xor(p[0], 1) + rbias;
        float tv[4]; int te[4]; float cur = logit;
#pragma unroll
        for (int k = 0; k < 4; ++k) { float bv = cur; int be = myexp;
#pragma unroll
            for (int off = 32; off >= 1; off >>= 1) { const float ov = __shfl_xor(bv, off); const int oe = __shfl_xor(be, off); if (ov > bv || (ov == bv && oe < be)) { bv = ov; be = oe; } }
            tv[k] = bv; te[k] = be; if (myexp == be) cur = -3.0e38f; }
        const float e1 = __expf(tv[1] - tv[0]), e2 = __expf(tv[2] - tv[0]), e3 = __expf(tv[3] - tv[0]); const float inv = 1.0f / (1.0f + e1 + e2 + e3);
        if (lane == 0) { { int* ep = F.w<int>(WS_EIDX) + (size_t)tok * 4; ep[0] = te[0]; ep[1] = te[1]; ep[2] = te[2]; ep[3] = te[3]; }
            *(f32x4*)(F.w<float>(WS_GATE) + (size_t)tok * 4) = (f32x4){inv, e1 * inv, e2 * inv, e3 * inv};
            atomicAdd((int*)&hist[te[0]], 1); atomicAdd((int*)&hist[te[1]], 1); atomicAdd((int*)&hist[te[2]], 1); atomicAdd((int*)&hist[te[3]], 1); }
            }
    }
#undef PM_LOAD
    __syncthreads();
    if (tid < 32) F.w<int>(WS_BCNT)[F.bid * 32 + tid] = hist[tid];
}

__device__ __forceinline__ void phase_place(const Frame& F, int l) {
    const int tid = F.tid; LAS int* sm = (LAS int*)F.lds;
    __syncthreads();
    const int* bc = F.w<int>(WS_BCNT);
    if (tid < 96) sm[tid] = 0;
    __syncthreads();
    { int tot = 0, before = 0; for (int bb = tid >> 5; bb < F.G; bb += 16) { const int v = bc[bb * 32 + (tid & 31)]; tot += v; if (bb < F.bid) before += v; }
      atomicAdd((int*)&sm[tid & 31], tot); atomicAdd((int*)&sm[64 + (tid & 31)], before); }
    __syncthreads();
    if (tid == 0) { int acc = 0; for (int e = 0; e < 32; ++e) { sm[32 + e] = acc * 256; acc += (sm[e] + 255) >> 8; } sm[96] = acc; }
    __syncthreads();
    if (F.bid == 0 && tid < 33) { int* tp = F.w<int>(WS_TILEP) + l * 128; if (tid < 32) { tp[tid] = sm[32 + tid] >> 8; tp[64 + tid] = sm[tid]; } else tp[32] = sm[96]; }
    int* rtok = F.w<int>(WS_RTOK); float* rgate = F.w<float>(WS_RGATE); int* rslot = F.w<int>(WS_RSLOT);
    for (int e = F.bid; e < 32; e += F.G) { const int s0 = sm[32 + e] + sm[e], s1 = sm[32 + e] + (((sm[e] + 255) >> 8) << 8); for (int i = s0 + tid; i < s1; i += 512) rtok[i] = 0; }
    const int tpb = (NL + F.G - 1) / F.G; const int t0 = F.bid * tpb, t1 = (t0 + tpb < NL) ? t0 + tpb : NL; const int na = (t1 - t0) * 4;
    const int* eidx = F.w<int>(WS_EIDX); const float* gate = F.w<float>(WS_GATE);
    for (int i = tid; i < na; i += 512) sm[128 + i] = eidx[(size_t)t0 * 4 + i];
    __syncthreads();
    for (int i = tid; i < na; i += 512) { const int e = sm[128 + i]; int rank = 0; for (int k = 0; k < i; ++k) rank += (sm[128 + k] == e) ? 1 : 0;
        const int pos = sm[32 + e] + sm[64 + e] + rank; const int asg = t0 * 4 + i;
        rtok[pos] = asg >> 2; rgate[pos] = gate[asg]; rslot[pos] = asg; }
    __syncthreads();
}

__device__ __forceinline__ void phase_combine(const Frame& F, int l) {
    const ArgsView a{ArgV{F.ap}, (float*)(GAS float*)F.ap->out}; const int lane = F.lane; bf16_t* X1 = F.w<bf16_t>(WS_X1); const unsigned char* YS = F.w<unsigned char>(WS_YS); bf16_t* H = F.w<bf16_t>(WS_H);
    const float* gpost = a.in[I_NFPOST] + l * 1024; const float* gpre1 = a.in[I_NMPRE] + 1024;
    float hA[16], hB[16], hC[16]; int cb = -1;
    u32x2 nys[2][4]; u32x4 nx1[2];
#define CB_LOAD(t) do { _Pragma("unroll") for (int hb = 0; hb < 2; ++hb) { const int c0 = hb * 512 + lane * 8; _Pragma("unroll") for (int k = 0; k < 4; ++k) nys[hb][k] = *(const u32x2*)(YS + ((size_t)(t) * 4 + k) * 1024 + c0); \
        nx1[hb] = *(const u32x4*)(X1 + (size_t)(t) * 1024 + c0); } } while (0)
    if (F.bid * 8 + F.wave < NL) CB_LOAD(F.bid * 8 + F.wave);
    for (int tok = F.bid * 8 + F.wave; tok < NL; tok += F.G * 8) {
        const int b = tok / SEQ;
        if (b != cb) { cb = b; const float* md = F.mod(l, b); const float* md1 = F.mod(1, b);
#pragma unroll
            for (int hb = 0; hb < 2; ++hb) { const int c0 = hb * 512 + lane * 8;
#pragma unroll
                for (int q = 0; q < 8; ++q) { hA[hb * 8 + q] = md[5120 + c0 + q] * gpost[c0 + q]; hB[hb * 8 + q] = gpre1[c0 + q] * (1.0f + md1[1024 + c0 + q]); hC[hb * 8 + q] = md1[c0 + q]; } } }
        float f[16]; float ss = 0.f; u32x4 cx[2];
#pragma unroll
        for (int hb = 0; hb < 2; ++hb) { float acc[8] = {0, 0, 0, 0, 0, 0, 0, 0};
#pragma unroll
            for (int k = 0; k < 4; ++k) { float v[8]; unpack8_fp8(nys[hb][k], v);
#pragma unroll
                for (int q = 0; q < 8; ++q) acc[q] += v[q]; }
#pragma unroll
            for (int q = 0; q < 8; ++q) { const float fv = acc[q] * (1.0f / FP8_Y_SCALE); f[hb * 8 + q] = fv; ss += fv * fv; }
            cx[hb] = nx1[hb]; }
        if (tok + F.G * 8 < NL) CB_LOAD(tok + F.G * 8);
        ss = wave_sum(ss); const float rstd = __builtin_amdgcn_rsqf(ss * (1.0f / 1024.0f) + EPSF);
        float x[16]; float s1 = 0.f;
#pragma unroll
        for (int hb = 0; hb < 2; ++hb) { const int c0 = hb * 512 + lane * 8; float xr[8]; unpack8(cx[hb], xr);
#pragma unroll
            for (int q = 0; q < 8; ++q) { const float v = xr[q] + hA[hb * 8 + q] * (f[hb * 8 + q] * rstd); x[hb * 8 + q] = v; s1 += v * v; }
            if (l == 0) *(u32x4*)(X1 + (size_t)tok * 1024 + c0) = pack8(*(const float (*)[8])&x[hb * 8]);
            else { float* dst = a.out + (size_t)tok * 1024 + c0;
                *(f32x4*)(dst) = (f32x4){x[hb * 8], x[hb * 8 + 1], x[hb * 8 + 2], x[hb * 8 + 3]}; *(f32x4*)(dst + 4) = (f32x4){x[hb * 8 + 4], x[hb * 8 + 5], x[hb * 8 + 6], x[hb * 8 + 7]}; } }
        if (l == 0) { s1 = wave_sum(s1); const float rstd1 = __builtin_amdgcn_rsqf(s1 * (1.0f / 1024.0f) + EPSF);
#pragma unroll
            for (int hb = 0; hb < 2; ++hb) { const int c0 = hb * 512 + lane * 8; float o[8];
#pragma unroll
                for (int q = 0; q < 8; ++q) o[q] = x[hb * 8 + q] * rstd1 * hB[hb * 8 + q] + hC[hb * 8 + q];
                *(u32x2*)((unsigned char*)H + (size_t)tok * 1024 + c0) = pack8_fp8(o, FP8_ACT_SCALE); } }
    }
}

__device__ __forceinline__ void phase_lnT(const Frame& F) {
    const ArgsView a{ArgV{F.ap}, (float*)(GAS float*)F.ap->out}; const int lane = F.lane, tid = F.tid; const bf16_t* V1 = F.w<bf16_t>(WS_V1); bf16_t* VT = F.w<bf16_t>(WS_VT);
    LAS float* st = (LAS float*)F.lds;
    LAS bf16_t* tl = (LAS bf16_t*)(F.lds + 1024);
    LAS float* wl = (LAS float*)(F.lds + 1024 + 2 * 34816);
    const float* gw = a.in[I_GMVW]; const float* gb = a.in[I_GMVB];
    __syncthreads();
    for (int i = tid; i < 1024; i += 512) { wl[i] = gw[i]; wl[1024 + i] = gb[i]; }
    for (int n = F.bid; n < NL / 128; n += F.G) {
        __syncthreads();
#pragma unroll 1
        for (int bt = 0; bt < 2; ++bt) { const int r0 = F.wave * 16 + bt * 8; const bf16_t* rows = V1 + ((size_t)n * 128 + r0) * 1024 + lane * 8;
            u32x4 rv[8][2];
#pragma unroll
            for (int i = 0; i < 8; ++i) { rv[i][0] = *(const u32x4*)(rows + i * 1024); rv[i][1] = *(const u32x4*)(rows + i * 1024 + 512); }
            float sm[8], sq[8];
#pragma unroll
            for (int i = 0; i < 8; ++i) { float t0[8], t1[8]; unpack8(rv[i][0], t0); unpack8(rv[i][1], t1); float s_ = 0.f, q_ = 0.f;
#pragma unroll
                for (int q = 0; q < 8; ++q) { s_ += t0[q] + t1[q]; q_ += t0[q] * t0[q] + t1[q] * t1[q]; }
                sm[i] = s_; sq[i] = q_; }
#pragma unroll
            for (int i = 0; i < 8; ++i) { sm[i] = wave_sum(sm[i]); sq[i] = wave_sum(sq[i]); }
            if (lane == 0) {
#pragma unroll
                for (int i = 0; i < 8; ++i) { const float mu = sm[i] * (1.0f / 1024.0f); const float var = fmaxf(sq[i] * (1.0f / 1024.0f) - mu * mu, 0.f); st[(r0 + i) * 2] = mu; st[(r0 + i) * 2 + 1] = __builtin_amdgcn_rsqf(var + 1e-5f); } } }
        __syncthreads();
        { const int r = tid >> 2, cq = (tid & 3) * 32; const float mu = st[r * 2], rs = st[r * 2 + 1]; const bf16_t* src = V1 + ((size_t)n * 128 + r) * 1024 + cq;
          const int ch2 = tid >> 2, tq = (tid & 3) * 32;
          u32x4 cur4[4];
#pragma unroll
          for (int c8 = 0; c8 < 4; ++c8) cur4[c8] = *(const u32x4*)(src + c8 * 8);
#pragma unroll
          for (int g = 0; g < 8; ++g) { LAS bf16_t* tb = tl + (g & 1) * (34816 / 2);
              u32x4 nxt4[4];
              if (g + 1 < 8) {
#pragma unroll
                  for (int c8 = 0; c8 < 4; ++c8) nxt4[c8] = *(const u32x4*)(src + (g + 1) * 128 + c8 * 8); }
#pragma unroll
              for (int c8 = 0; c8 < 4; ++c8) { float t[8]; unpack8(cur4[c8], t); const LAS float* wp = wl + g * 128 + cq + c8 * 8;
                  const f32x4 w0 = *(const LAS f32x4*)wp, w1 = *(const LAS f32x4*)(wp + 4), b0 = *(const LAS f32x4*)(wp + 1024), b1 = *(const LAS f32x4*)(wp + 1028);
#pragma unroll
                  for (int q = 0; q < 8; ++q) { const int ch = cq + c8 * 8 + q; tb[ch * 136 + r] = f2bf((t[q] - mu) * rs * (q < 4 ? w0[q & 3] : w1[q & 3]) + (q < 4 ? b0[q & 3] : b1[q & 3])); } }
              __syncthreads();
              { bf16_t* dst = VT + ((size_t)n * 1024 + g * 128 + ch2) * 128 + tq;
#pragma unroll
                for (int c8 = 0; c8 < 4; ++c8) *(u32x4*)(dst + c8 * 8) = *(const LAS u32x4*)(tb + ch2 * 136 + tq + c8 * 8); }
              if (g + 1 < 8) {
#pragma unroll
                  for (int c8 = 0; c8 < 4; ++c8) cur4[c8] = nxt4[c8]; }
          } }
    }
}
constexpr int LDS_MISC = 131072, LDS_BARW = LDS_MISC + 2048, LDS_BYTES = 147456;
#ifndef MK_PER_PHASE
#define MK_PER_PHASE 0
#endif
constexpr int NPHASE = 30;
__host__ __device__ constexpr bool barrier_after(int k) { return !(k == 3 || k == 4 || k == 6 || k == 11 || k == 13 || k == NPHASE - 1); }

#ifndef ATT_BODY
#define ATT_BODY attn_body
#endif
template <int K>
__device__ __forceinline__ void run_phase(Frame& F) {
    LAS unsigned char* ring = F.lds;
    if constexpr (K == 0) phase_prologue(F);
    else if constexpr (K == 1) phase_h0(F);
    else if constexpr (K == 2) { pg8::Gemm g{F.w<bf16_t>(WS_H), F.w<bf16_t>(WS_WIN), 1024, 1024, 1024}; pg8::StaticOrder S; S.init(NR, PW, F.G, F.bid);
        epi::POut E{F.w<bf16_t>(WS_P), F.w<float>(WS_SSQ)}; pg8::gemm_phase(ring, g, S, E, F.tid); }
    else if constexpr (K == 3) { pg8::Gemm g{F.w<bf16_t>(WS_P), F.w<bf16_t>(WS_WUQ), PW, 256, 256}; pg8::StaticOrder S; S.init(NR, 768, F.G, F.bid, 1);
        epi::QOut E{F.w<bf16_t>(WS_Q), F.w<float>(WS_SSQ), F.w<float>(WS_ROPE)}; pg8::gemm_phase(ring, g, S, E, F.tid); }
    else if constexpr (K == 4) { pg8::Gemm g{F.w<bf16_t>(WS_P) + 256, F.w<bf16_t>(WS_WUKV), PW, 128, 128}; pg8::StaticOrder S; S.init(NR, 1024, F.G, (F.bid + F.G / 2) % F.G);
        epi::KVOut E{F.w<bf16_t>(WS_K), F.w<bf16_t>(WS_V), F.w<float>(WS_SSQ)}; pg8::gemm_phase(ring, g, S, E, F.tid); }
    else if constexpr (K == 5) phase_rwprep(F);
    else if constexpr (K == 6) { pg8::Gemm g{F.w<bf16_t>(WS_LA), F.w<bf16_t>(WS_WLORA), 128, 128, 128}; pg8::StaticOrder S; S.init(NR, 2048, F.G, F.bid);
        epi::LoraOut E{F.w<bf16_t>(WS_LW), F.w<bf16_t>(WS_AA), F.in(I_W0), F.in(I_A0)}; pg8::gemm_phase(ring, g, S, E, F.tid); }
    else if constexpr (K == 7) { pg8::Gemm g{F.w<bf16_t>(WS_GA), F.w<bf16_t>(WS_WG2), 128, 128, 128}; pg8::StaticOrder S; S.init(NR, 512, F.G, F.bid, 1);
        epi::Bf16Out<0> E{F.w<bf16_t>(WS_GG), 512, 0, 0}; pg8::gemm_phase(ring, g, S, E, F.tid); }
    else if constexpr ((K >= 8 && K <= 13 && K != 12)) {
#define MKRP() rw::Ptrs RP{F.w<bf16_t>(WS_LW), F.w<bf16_t>(WS_AA), F.w<bf16_t>(WS_RWR), F.w<bf16_t>(WS_RWK), F.w<bf16_t>(WS_RWV), F.w<bf16_t>(WS_RWKK), F.in(I_KA), \
                    F.w<u32x4>(WS_RG), F.w<u32x4>(WS_RH), F.w<u32x4>(WS_RRH), F.w<u32x4>(WS_RY0), F.w<u32x4>(WS_ZS), F.w<float>(WS_YR), F.w<float>(WS_YRB), F.w<bf16_t>(WS_GGRP), F.w<u32x4>(WS_HGRP), F.w<u32x4>(WS_ZGRP)};
        if constexpr (K == 8) {
            if (F.wave < 6) { if (F.probe_skip == 1) return; MKRP(); LAS float* wl = (LAS float*)(F.lds + F.wave * 12800); for (int item = F.bid * 6 + F.wave; item < NCHAIN * NCH; item += F.G * 6) rw::r1_item(RP, item, wl); }
            else if (F.probe_skip != 2) cvt_moe_weights(F, F.bid * 2 + (F.wave - 6), F.G * 2, 6 * 12800 + (F.wave - 6) * 16640); }
        else if constexpr (K == 9) { MKRP(); for (int task = F.bid * 8 + F.wave; task < NCHAIN * rw::NGRP * 4; task += F.G * 8) rw::r2a_task(RP, task, F.lane); }
        else if constexpr (K == 10) {
            const int nr2 = F.G < 64 ? F.G : 64;
            if (F.wave == 0 && F.bid < nr2) { MKRP(); for (int item = F.bid; item < 2 * NCHAIN; item += nr2) rw::r2b_item(RP, item, F.lane); } }
        else if constexpr (K == 11) { MKRP(); for (int task = F.bid * 8 + F.wave; task < NCHAIN * rw::NGRP * 2; task += F.G * 8) rw::r2c_task(RP, task, F.lane); }
        else { }
    }
    else if constexpr (K == 12) {
        const bf16_t* Qp = F.w<bf16_t>(WS_Q); const bf16_t* Kp = F.w<bf16_t>(WS_K); const bf16_t* Vp = F.w<bf16_t>(WS_V); bf16_t* MIX = F.w<bf16_t>(WS_MIX);
        for (int rnd = 0;; ++rnd) {
            int pair, qb;
            if (F.G == 256) { if (rnd >= 4) break; const int xcd = F.bid & 7, slot = F.bid >> 3; pair = 2 * xcd + (rnd >> 1); qb = (rnd & 1) * 32 + slot; }
            else { const int u = rnd * F.G + F.bid; if (u >= 1024) break; pair = u >> 6; qb = u & 63; }
            const int b = pair >> 3, h = pair & 7;
            att::ATT_BODY<0>(Qp + ((size_t)(b * 8 + h) * SEQ + qb * 256) * 96, Kp + (size_t)(b * 8 + h) * SB * 96, Vp + (size_t)(b * 8 + h) * SB * 64,
                           MIX + ((size_t)b * SEQ + qb * 256) * 1024 + h * 64, 1024, SB, F.ldsg, F.tid);
        }
    }
#ifdef ATT_EXP
    else if constexpr (K == 14) { phase_readout(F); __syncthreads();
        const bf16_t* Qp = F.w<bf16_t>(WS_Q); const bf16_t* Kp = F.w<bf16_t>(WS_K); const bf16_t* Vp = F.w<bf16_t>(WS_V); bf16_t* DUM = F.w<bf16_t>(WS_ACT);
        for (int rnd = 0; rnd < 4; ++rnd) { const int xcd = F.bid & 7, slot = F.bid >> 3; const int pair = 2 * xcd + (rnd >> 1), qb = (rnd & 1) * 32 + slot; const int b = pair >> 3, h = pair & 7;
            att::ATT_BODY<ATT_EXP>(Qp + ((size_t)(b * 8 + h) * SEQ + qb * 256) * 96, Kp + (size_t)(b * 8 + h) * SB * 96, Vp + (size_t)(b * 8 + h) * SB * 64,
                           DUM + ((size_t)b * SEQ + qb * 256) * 1024 + h * 64, 1024, SB, F.ldsg, F.tid); } }
#else
    else if constexpr (K == 14) phase_readout(F);
#endif
    else if constexpr (K == 15) { pg8::Gemm g{F.w<bf16_t>(WS_MIX), F.w<bf16_t>(WS_WOUT), 1024, 1024, 1024}; pg8::StaticOrder S; S.init(NL, 1024, F.G, F.bid);
        epi::Bf16Out<0> E{F.w<bf16_t>(WS_Y), 1024, 0, 0}; pg8::gemm_phase(ring, g, S, E, F.tid); }
    else if constexpr (K == 21) { pg8::Gemm g{F.w<bf16_t>(WS_H), F.w<bf16_t>(WS_WGMIN), 512, 512, 512}; pg8::StaticOrder S; S.init(NL, 2048, F.G, F.bid);
        epi::Bf16Out<1, 1> E{F.w<bf16_t>(WS_U), 1024, 1024, (WS_V1 - WS_U) / 2}; pg8::gemm_phase<epi::Bf16Out<1, 1>, pg8::StaticOrder, true>(ring, g, S, E, F.tid); }
    else if constexpr (K == 22) phase_lnT(F);
    else if constexpr (K == 23) { pg8::Gemm g{F.w<bf16_t>(WS_WS), F.w<bf16_t>(WS_VT), 128, 128, 128}; pg8::SpatialOrder S{F.G, F.bid};
        epi::SpatialOut E{F.w<bf16_t>(WS_U), F.w<unsigned char>(WS_UV), F.in(I_GMBS)}; pg8::gemm_phase(ring, g, S, E, F.tid); }
    else if constexpr (K == 24) { pg8::Gemm g{F.w<bf16_t>(WS_UV), F.w<bf16_t>(WS_WGMOUT), 512, 512, 512}; pg8::StaticOrder S; S.init(NL, 1024, F.G, F.bid);
        epi::Bf16Out<0, 1> E{F.w<bf16_t>(WS_Y), 1024, 0, 0}; pg8::gemm_phase<epi::Bf16Out<0, 1>, pg8::StaticOrder, true>(ring, g, S, E, F.tid); }
    else {
        constexpr int l = (K >= 25) ? 1 : 0; constexpr int q = K - (l ? 25 : 16);
        if constexpr (q == 0) phase_postmix(F, l);
        else if constexpr (q == 1) phase_place(F, l);
        else if constexpr (q == 4) phase_combine(F, l);
        else {
            LAS int* tpfx = (LAS int*)(F.lds + LDS_MISC + 256); LAS int* cnt = (LAS int*)(F.lds + LDS_MISC + 512);
            LAS unsigned char* t2e = (LAS unsigned char*)(F.lds + LDS_MISC + 768);
            __syncthreads(); { const int* tp = F.w<int>(WS_TILEP) + l * 128; if (F.tid < 33) tpfx[F.tid] = tp[F.tid]; if (F.tid < 32) cnt[F.tid] = tp[64 + F.tid]; } __syncthreads();
            for (int t = F.tid; t < 544; t += 512) { int e = 0; for (int k = 1; k < 32; ++k) e += (tpfx[k] <= t) ? 1 : 0; t2e[t] = (unsigned char)e; } __syncthreads();
            if constexpr (q == 2) { pg8::Gemm g{F.w<bf16_t>(WS_HF), (const bf16_t*)(F.w<unsigned char>(WS_WGU) + (size_t)l * 32 * 2048 * 1024), 512, 512, 512};
                pg8::MoeOrder<true, 8, 2048 * 1024> S{F.G, F.bid, F.lds + LDS_MISC, F.w<int>(WS_RTOK)};
                epi::Moe1Out E{F.w<unsigned char>(WS_ACT), F.in(I_BGU) + (size_t)l * 32 * 2048, F.lds + LDS_MISC + 4096}; pg8::gemm_phase<epi::Moe1Out, pg8::MoeOrder<true, 8, 2048 * 1024>, true>(ring, g, S, E, F.tid); }
            else { pg8::Gemm g{F.w<bf16_t>(WS_ACT), (const bf16_t*)(F.w<unsigned char>(WS_WDN) + (size_t)l * 32 * 1024 * 1024), 512, 512, 512};
                pg8::MoeOrder<false, 4, 1024 * 1024> S{F.G, F.bid, F.lds + LDS_MISC, F.w<int>(WS_RTOK)};
                epi::Moe2Out E{F.w<unsigned char>(WS_YS), F.in(I_BDN) + (size_t)l * 32 * 1024, F.w<int>(WS_RSLOT), F.w<float>(WS_RGATE), F.lds + LDS_MISC + 4096}; pg8::gemm_phase<epi::Moe2Out, pg8::MoeOrder<false, 4, 1024 * 1024>, true>(ring, g, S, E, F.tid); }
        }
    }
}

template <int K, int HI>
__device__ __forceinline__ void run_range(Frame& F, const XcdBarrier& bar, unsigned char* ws_arg) {
    if constexpr (K < HI) {
        { int t_ = threadIdx.x; asm volatile("" : "+v"(t_)); F.tid = t_; F.lane = t_ & 63; F.wave = __builtin_amdgcn_readfirstlane(t_ >> 6);
          size_t z_ = 0; asm volatile("" : "+s"(z_)); F.ws = ws_arg + z_;     ArgP p_ = (ArgP)__builtin_amdgcn_kernarg_segment_ptr(); asm volatile("" : "+s"(p_)); F.ap = p_;
          int g_ = (int)gridDim.x; asm volatile("" : "+s"(g_)); F.G = g_; int b_ = (int)blockIdx.x; asm volatile("" : "+s"(b_)); F.bid = b_; }
        run_phase<K>(F);
#ifdef PROBE_PHASE
        if constexpr (K == PROBE_PHASE || K == PROBE_PHASE2) {
            xcd_barrier(bar);
            { int t_ = threadIdx.x; asm volatile("" : "+v"(t_)); F.tid = t_; F.lane = t_ & 63; F.wave = __builtin_amdgcn_readfirstlane(t_ >> 6); }
#ifdef PROBE_SKIP
            { int sk_ = PROBE_SKIP; asm volatile("" : "+s"(sk_)); F.probe_skip = sk_; }
#endif
            run_phase<K>(F); F.probe_skip = 0;
        }
#endif
        if constexpr (K + 1 < HI && barrier_after(K)) xcd_barrier(bar);
        run_range<K + 1, HI>(F, bar, ws_arg);
    }
}

template <int LO, int HI>
__global__ void __launch_bounds__(512, 2) fwd(Args args) {
    extern __shared__ __attribute__((aligned(16))) unsigned char lds_raw[];
    Frame F; F.lds = (LAS unsigned char*)lds_raw; F.ldsg = (char*)lds_raw; F.probe_skip = 0;
    XcdBarrier bar; bar.bar = (unsigned*)(args.ws + WS_CTL); bar.x = 0; bar.st = (volatile LAS unsigned*)(F.lds + LDS_BARW);
    if constexpr (HI - LO > 1) {
        if (threadIdx.x == 0) *(LAS u32x4*)(F.lds + LDS_BARW) = (u32x4){0u, 0u, 0u, 0u};
        __syncthreads();
        bar = xcd_barrier_post((unsigned*)(args.ws + WS_CTL), (volatile LAS unsigned*)(F.lds + LDS_BARW));
    }
    run_range<LO, HI>(F, bar, args.ws);
}

template <int K> static void launch_each(int grid, hipStream_t stream, const Args& a) {
    if constexpr (K < NPHASE) {
        hipFuncSetAttribute((const void*)fwd<K, K + 1>, hipFuncAttributeMaxDynamicSharedMemorySize, LDS_BYTES);
        hipLaunchKernelGGL((fwd<K, K + 1>), dim3(grid), dim3(512), LDS_BYTES, stream, a);
        launch_each<K + 1>(grid, stream, a);
    }
}
extern "C" void kernel_launch(void* const* d_in, const int* in_sizes, int n_in, void* d_out, int out_size, void* d_ws, size_t ws_size, hipStream_t stream) {
    static int grid = 0;
    if (grid == 0) {
        if (n_in != 40 || out_size != NL * DM || ws_size < WS_END) { fprintf(stderr, "kernel_launch: unexpected shapes: n_in %d out %d ws %zu (need %zu)\n", n_in, out_size, ws_size, (size_t)WS_END); grid = -1; return; }
        int dev = 0, cus = 0;
        if (hipGetDevice(&dev) != hipSuccess || hipDeviceGetAttribute(&cus, hipDeviceAttributeMultiprocessorCount, dev) != hipSuccess) { grid = -1; return; }
#if !MK_PER_PHASE
        int per_cu = 0;
        if (hipFuncSetAttribute((const void*)fwd<0, NPHASE>, hipFuncAttributeMaxDynamicSharedMemorySize, LDS_BYTES) != hipSuccess) { fprintf(stderr, "kernel_launch: hipFuncSetAttribute failed\n"); grid = -1; return; }
        if (hipOccupancyMaxActiveBlocksPerMultiprocessor(&per_cu, (const void*)fwd<0, NPHASE>, 512, LDS_BYTES) != hipSuccess || per_cu < 1) fprintf(stderr, "kernel_launch: occupancy query says %d\n", per_cu);
        (void)hipGetLastError();
#endif
        grid = cus > 256 ? 256 : cus;
    }
    if (grid < 0) return;
    (void)hipMemsetAsync((char*)d_ws + WS_CTL, 0, CTL_BYTES, stream);
    Args a{};
    for (int i = 0; i < 40; ++i) a.in[i] = (const float*)d_in[i];
    a.out = (float*)d_out; a.ws = (unsigned char*)d_ws; a.ph_lo = 0; a.ph_hi = NPHASE;
#if MK_PER_PHASE
    launch_each<0>(grid, stream, a);
#else
    hipLaunchKernelGGL((fwd<0, NPHASE>), dim3(grid), dim3(512), LDS_BYTES, stream, a);
#endif
    const hipError_t le = hipPeekAtLastError();
    if (le != hipSuccess) fprintf(stderr, "kernel_launch: launch failed: %s\n", hipGetErrorName(le));
}
```
